# Optimizing an MI355X kernel written in HIP

```python
import jax, jax.numpy as jnp
from jax import lax
import numpy as np

D_MODEL = 1024
BATCH = 16
SEQ = 256
DEPTH = 2
DEC_BATCH = 4
DEC_SEQ = 2048
PAST_LEN = 512

GRID_W = 64
N_MIXERS = 2
N_RWKV = (DEPTH + 1) // 2
N_SGU = DEPTH // 2
RW_HEAD_DIM = 64
RW_HEADS = D_MODEL // RW_HEAD_DIM
DECAY_LORA = 64
AAA_LORA = 64
GATE_LORA = 128
N_SHIFT = 6
SGU_WIDTH = 2 * D_MODEL
SGU_GROUPS = 8
CHUNK = 128
FFN_HIDDEN = 2816
CONV_W = 3
N_MOD = 6
RMS_EPS = 1e-6
LN_EPS = 1e-5
GN_EPS = 64e-5

kernel_name = "hybrid_rwkv7_sgu_convffn_diffusion_step"


def rmsnorm(x, g):
    xf = x.astype(jnp.float32)
    y = xf * lax.rsqrt(jnp.mean(xf * xf, axis=-1, keepdims=True) + RMS_EPS)
    return (y * g.astype(jnp.float32)).astype(x.dtype)


def layernorm(x, g, b):
    xf = x.astype(jnp.float32)
    mu = jnp.mean(xf, axis=-1, keepdims=True)
    var = jnp.mean(jnp.square(xf - mu), axis=-1, keepdims=True)
    y = (xf - mu) * lax.rsqrt(var + LN_EPS)
    return (y * g.astype(jnp.float32) + b.astype(jnp.float32)).astype(x.dtype)


def shift_seq(x):
    prev = jnp.pad(x[:, :-1], ((0, 0), (1, 0), (0, 0)))
    nxt = jnp.pad(x[:, 1:], ((0, 0), (0, 1), (0, 0)))
    return prev, nxt


def wkv_scan(r, w, k, v, aa, bb, s0, reverse):
    xs = tuple(jnp.moveaxis(t, 1, 0) for t in (r, w, k, v, aa, bb))

    def step(S, inp):
        r_t, w_t, k_t, v_t, a_t, b_t = inp
        sa = jnp.einsum('bhij,bhj->bhi', S, a_t)
        S = S * w_t[:, :, None, :] + sa[..., None] * b_t[:, :, None, :] + v_t[..., None] * k_t[:, :, None, :]
        y = jnp.einsum('bhij,bhj->bhi', S, r_t)
        return S, y

    S, ys = lax.scan(step, s0, xs, reverse=reverse)
    return jnp.moveaxis(ys, 0, 1), S


def rwkv7_mix(h, s0_fwd, s0_bwd, mu, w_r, w_k, w_v, w_o, w0, w1, w2, a0, a1, a2, g1, g2,
              k_k, k_a, r_k, lnx_w, lnx_b):
    B, T, D = h.shape
    H, K = RW_HEADS, RW_HEAD_DIM
    f32 = jnp.float32
    heads = lambda t: t.reshape(B, T, H, K).astype(f32)
    prev, nxt = shift_seq(h)
    xs = h[:, :, None, :] + (prev - h)[:, :, None, :] * mu[0] + (nxt - h)[:, :, None, :] * mu[1]
    xr, xw, xk, xv, xa, xg = [xs[:, :, i] for i in range(N_SHIFT)]
    r = xr @ w_r
    k = xk @ w_k
    v = xv @ w_v
    g = jax.nn.sigmoid(xg @ g1) @ g2
    rh, kh, vh = heads(r), heads(k), heads(v)
    kk = kh * k_k.reshape(H, K).astype(f32)
    kk = kk / jnp.maximum(jnp.sqrt(jnp.sum(kk * kk, axis=-1, keepdims=True)), 1e-12)
    y = jnp.zeros_like(rh)
    k_bonus = jnp.zeros_like(kh)
    finals = []
    for d, (s0, rev) in enumerate(((s0_fwd, False), (s0_bwd, True))):
        w_raw = (w0[d] + jnp.tanh(xw @ w1[d]) @ w2[d]).astype(f32)
        decay = jnp.exp(-jnp.exp(-jax.nn.softplus(-w_raw) - 0.5))
        a = heads(jax.nn.sigmoid((a0[d] + (xa @ a1[d]) @ a2[d]).astype(f32)))
        kd = kh * (1.0 + (a - 1.0) * k_a.reshape(H, K).astype(f32))
        yd, sd = wkv_scan(rh, heads(decay), kd, vh, -kk, kk * a, s0.astype(f32), rev)
        y = y + yd
        k_bonus = k_bonus + kd
        finals.append(sd.astype(h.dtype))
    mean = jnp.mean(y, axis=-1, keepdims=True)
    var = jnp.mean(jnp.square(y - mean), axis=-1, keepdims=True)
    yn = (y - mean) * lax.rsqrt(var + GN_EPS)
    yn = yn * lnx_w.reshape(H, K).astype(f32) + lnx_b.reshape(H, K).astype(f32)
    yn = yn + jnp.sum(rh * k_bonus * r_k.astype(f32), axis=-1, keepdims=True) * vh
    out = (yn.reshape(B, T, D).astype(h.dtype) * g) @ w_o
    return out, finals[0], finals[1]


def sgu_mix(h, w_in, ln_w, ln_b, w_s, b_s, w_out):
    B, T, _ = h.shape
    z = jax.nn.gelu(h @ w_in, approximate=False)
    u, v = jnp.split(z, 2, axis=-1)
    v = layernorm(v, ln_w, ln_b)
    vc = v.reshape(B, T // CHUNK, CHUNK, SGU_GROUPS, SGU_WIDTH // SGU_GROUPS)
    vm = jnp.einsum('gpq,bnqgc->bnpgc', w_s, vc) + b_s.T[:, :, None]
    return (u * vm.reshape(B, T, SGU_WIDTH)) @ w_out


def conv_ffn(h, w_up, w_conv, b_conv, w_down, on_grid):
    B, T, _ = h.shape
    up = h @ w_up
    C = up.shape[-1]
    if on_grid:
        rows = T // GRID_W
        img = up.reshape(B, rows, GRID_W, C)
        img = lax.conv_general_dilated(img, w_conv[:, :, None, :], (1, 1), 'SAME',
                                       dimension_numbers=('NHWC', 'HWIO', 'NHWC'),
                                       feature_group_count=C)
        up = img.reshape(B, T, C)
    else:
        prev, nxt = shift_seq(up)
        up = prev * w_conv[1, 0] + up * w_conv[1, 1] + nxt * w_conv[1, 2]
    up = up + b_conv
    val, gate = jnp.split(up, 2, axis=-1)
    return (jax.nn.silu(gate) * val) @ w_down


def setup_inputs(seed: int = 0) -> dict:
    key = jax.random.key(seed)
    keys = iter(jax.random.split(key, 48))
    D, H, K, F, E, G = D_MODEL, RW_HEADS, RW_HEAD_DIM, FFN_HIDDEN, SGU_WIDTH, SGU_GROUPS

    def nrm(shape, scale):
        return jax.random.normal(next(keys), shape, jnp.float32) * scale

    def gain(shape):
        return 1.0 + nrm(shape, 0.05)

    return {
        "x_prompt": nrm((BATCH, SEQ, D), 1.0),
        "x_sample": nrm((DEC_BATCH, DEC_SEQ, D), 1.0),
        "state_ctx_fwd": nrm((DEC_BATCH, N_RWKV, H, K, K), 0.5),
        "state_ctx_bwd": nrm((DEC_BATCH, N_RWKV, H, K, K), 0.5),
        "c": nrm((DEC_BATCH, D), 1.0),
        "c_ctx": nrm((D,), 1.0),
        "ada_w": nrm((DEPTH, D, N_MOD * D), 0.5 * D ** -0.5),
        "ada_b": nrm((DEPTH, N_MOD * D), 0.02),
        "norm_mix": gain((DEPTH, D)),
        "norm_ffn": gain((DEPTH, D)),
        "ffn_up": nrm((DEPTH, D, 2 * F), D ** -0.5),
        "ffn_conv": nrm((DEPTH, CONV_W, CONV_W, 2 * F), 1.0 / 3.0),
        "ffn_conv_b": nrm((DEPTH, 2 * F), 0.02),
        "ffn_down": nrm((DEPTH, F, D), F ** -0.5),
        "norm_final": gain((D,)),
        "rw_mu": jax.random.uniform(next(keys), (N_RWKV, 2, N_SHIFT, D), jnp.float32, 0.0, 0.5),
        "rw_wr": nrm((N_RWKV, D, D), D ** -0.5),
        "rw_wk": nrm((N_RWKV, D, D), D ** -0.5),
        "rw_wv": nrm((N_RWKV, D, D), D ** -0.5),
        "rw_wo": nrm((N_RWKV, D, D), D ** -0.5),
        "rw_w0": nrm((N_RWKV, 2, D), 0.5),
        "rw_w1": nrm((N_RWKV, 2, D, DECAY_LORA), D ** -0.5),
        "rw_w2": nrm((N_RWKV, 2, DECAY_LORA, D), 0.1 * DECAY_LORA ** -0.5),
        "rw_a0": nrm((N_RWKV, 2, D), 0.5),
        "rw_a1": nrm((N_RWKV, 2, D, AAA_LORA), D ** -0.5),
        "rw_a2": nrm((N_RWKV, 2, AAA_LORA, D), 0.1 * AAA_LORA ** -0.5),
        "rw_g1": nrm((N_RWKV, D, GATE_LORA), D ** -0.5),
        "rw_g2": nrm((N_RWKV, GATE_LORA, D), GATE_LORA ** -0.5),
        "rw_kk": 0.85 + nrm((N_RWKV, D), 0.05),
        "rw_ka": gain((N_RWKV, D)),
        "rw_rk": nrm((N_RWKV, H, K), 0.1),
        "rw_lnx_w": gain((N_RWKV, D)),
        "rw_lnx_b": nrm((N_RWKV, D), 0.02),
        "sg_in": nrm((N_SGU, D, 2 * E), D ** -0.5),
        "sg_ln_w": gain((N_SGU, E)),
        "sg_ln_b": nrm((N_SGU, E), 0.02),
        "sg_ws": nrm((N_SGU, G, CHUNK, CHUNK), CHUNK ** -0.5),
        "sg_bs": gain((N_SGU, G, CHUNK)),
        "sg_out": nrm((N_SGU, E, D), E ** -0.5),
    }


def reference(x_prompt, x_sample, state_ctx_fwd, state_ctx_bwd, c, c_ctx,
              ada_w, ada_b, norm_mix, norm_ffn, ffn_up, ffn_conv, ffn_conv_b, ffn_down, norm_final,
              rw_mu, rw_wr, rw_wk, rw_wv, rw_wo, rw_w0, rw_w1, rw_w2, rw_a0, rw_a1, rw_a2,
              rw_g1, rw_g2, rw_kk, rw_ka, rw_rk, rw_lnx_w, rw_lnx_b,
              sg_in, sg_ln_w, sg_ln_b, sg_ws, sg_bs, sg_out):

    def run_stream(x, cond, s0_fwd, s0_bwd, on_grid):
        new_f, new_b = [], []
        sc = jax.nn.silu(cond)
        for i in range(DEPTH):
            mod = (sc @ ada_w[i] + ada_b[i])[:, None, :]
            sh1, sc1, gt1, sh2, sc2, gt2 = jnp.split(mod, N_MOD, axis=-1)
            h = rmsnorm(x, norm_mix[i]) * (1.0 + sc1) + sh1
            j = i // N_MIXERS
            if i % N_MIXERS == 0:
                out, sf, sb = rwkv7_mix(h, s0_fwd[:, j], s0_bwd[:, j], rw_mu[j], rw_wr[j], rw_wk[j], rw_wv[j],
                                        rw_wo[j], rw_w0[j], rw_w1[j], rw_w2[j], rw_a0[j], rw_a1[j], rw_a2[j],
                                        rw_g1[j], rw_g2[j], rw_kk[j], rw_ka[j], rw_rk[j], rw_lnx_w[j], rw_lnx_b[j])
                new_f.append(sf)
                new_b.append(sb)
            else:
                out = sgu_mix(h, sg_in[j], sg_ln_w[j], sg_ln_b[j], sg_ws[j], sg_bs[j], sg_out[j])
            x = x + gt1 * out
            h = rmsnorm(x, norm_ffn[i]) * (1.0 + sc2) + sh2
            x = x + gt2 * conv_ffn(h, ffn_up[i], ffn_conv[i], ffn_conv_b[i], ffn_down[i], on_grid)
        return rmsnorm(x, norm_final), jnp.stack(new_f, axis=1), jnp.stack(new_b, axis=1)

    zero_state = jnp.zeros((x_prompt.shape[0], N_RWKV, RW_HEADS, RW_HEAD_DIM, RW_HEAD_DIM), x_prompt.dtype)
    y_prompt, new_state_fwd, new_state_bwd = run_stream(x_prompt, c_ctx[None, :], zero_state, zero_state, False)

    y_sample, _, _ = run_stream(x_sample, c, state_ctx_fwd, state_ctx_bwd, True)

    return (y_prompt, y_sample, new_state_fwd, new_state_bwd)
```

```cpp
#include <hip/hip_runtime.h>
#include <hip/hip_cooperative_groups.h>
#include <cstdio>
#include <cstdint>
namespace cg = cooperative_groups;

#ifndef ONE_LAUNCH
#define ONE_LAUNCH 1
#endif
#define REPMASK 0
#define XSYNC 0

typedef unsigned short bf16;
typedef unsigned v4u __attribute__((ext_vector_type(4)));
typedef unsigned v2u __attribute__((ext_vector_type(2)));
typedef float f32x4 __attribute__((ext_vector_type(4)));
typedef float f32x2 __attribute__((ext_vector_type(2)));
typedef short bf16x8 __attribute__((ext_vector_type(8)));
#define LAS __attribute__((address_space(3)))
#define LDS_WAIT() asm volatile("s_waitcnt lgkmcnt(0)" ::: "memory")

constexpr int D = 1024, MP = 4096, MS = 8192, M = MP + MS, FH = 2816, F2 = 5632, E = 2048;
constexpr size_t MiB = 1u << 20;
constexpr size_t OFF_MOD = 0;
constexpr size_t OFF_BAR = 512 * 1024;
constexpr size_t OFF_BON = 1 * MiB;
constexpr size_t OFF_BIAS = 2 * MiB + 512 * 1024;
constexpr size_t BIAS0 = OFF_BIAS, BIAS1 = BIAS0 + 5 * 5632 * 4, BIAS2 = BIAS1 + 5 * 4096 * 4;
constexpr size_t OFF_SSQ = OFF_BIAS + 300 * 1024;
constexpr size_t OFF_W = 3 * MiB;
constexpr size_t OFF_A = 34 * MiB;
constexpr size_t WS_NEED = 256 * MiB;
constexpr size_t OFF_W2 = 232 * MiB;
constexpr size_t X_SGIN = OFF_W2, X_SGOUT = OFF_W2 + 8 * MiB, X_UP1 = OFF_W2 + 12 * MiB, X_WS = OFF_W2 + 23 * MiB;
constexpr size_t W_RKV = 0, W_O = 6 * MiB, W_L1 = 8 * MiB, W_G2 = 9 * MiB + 512 * 1024, W_W2 = 10 * MiB, W_A2 = 10 * MiB + 256 * 1024, W_UP = 10 * MiB + 512 * 1024, W_DN = 21 * MiB + 512 * 1024;
constexpr size_t W1_SGIN = 0, W1_SGOUT = 8 * MiB, W1_UP = 12 * MiB, W1_DN = 23 * MiB, W1_WS = 28 * MiB + 512 * 1024;
constexpr size_t SL = 24 * MiB;
constexpr size_t A_L1 = 144 * MiB, A_G = 156 * MiB;
constexpr size_t A_H = 0, A_UP = 66 * MiB, A_ACT = 0;
constexpr size_t A_U = 24 * MiB, A_V = 72 * MiB, A_H2 = 120 * MiB;
constexpr int LDS_BYTES = 136 * 1024;
constexpr int NPH = 21;

struct Params {
    const float* in[39];
    float* out;
    unsigned char* ws;
    int ph_lo, ph_hi;
};

__device__ __forceinline__ unsigned f2bf(float f) { unsigned u = __builtin_bit_cast(unsigned, f); return (u + 0x7fffu + ((u >> 16) & 1u)) >> 16; }
__device__ __forceinline__ unsigned pk2(float lo, float hi) { unsigned r; asm("v_cvt_pk_bf16_f32 %0, %1, %2" : "=v"(r) : "v"(lo), "v"(hi)); return r; }
__device__ __forceinline__ float bflo(unsigned u) { return __builtin_bit_cast(float, u << 16); }
__device__ __forceinline__ float bfhi(unsigned u) { return __builtin_bit_cast(float, u & 0xffff0000u); }
__device__ __forceinline__ f32x4 unpack4(v2u a) { return (f32x4){bflo(a.x), bfhi(a.x), bflo(a.y), bfhi(a.y)}; }
__device__ __forceinline__ v2u pack4(f32x4 v) { v2u o; o.x = pk2(v.x, v.y); o.y = pk2(v.z, v.w); return o; }
__device__ __forceinline__ float wave_sum(float v) {
#pragma unroll
    for (int o = 1; o < 64; o <<= 1) v += __shfl_xor(v, o);
    return v;
}
template <int CTRL> __device__ __forceinline__ float dppf(float x) { return __builtin_bit_cast(float, __builtin_amdgcn_update_dpp(0, __builtin_bit_cast(int, x), CTRL, 0xF, 0xF, true)); }
__device__ __forceinline__ float red4(float x) { x += dppf<0xB1>(x); x += dppf<0x4E>(x); return x; }
__device__ __forceinline__ float red8(float x) { x = red4(x); x += dppf<0x141>(x); return x; }
__device__ __forceinline__ float red8s(float x) { x += dppf<0xB1>(x); asm("" : "+v"(x)); x += dppf<0x4E>(x); asm("" : "+v"(x)); x += dppf<0x141>(x); asm("" : "+v"(x)); return x; }
__device__ __forceinline__ float sigmoidf_(float x) { return 1.0f / (1.0f + __expf(-x)); }
__device__ __forceinline__ float tanhf_(float x) { return 1.0f - 2.0f / (1.0f + __expf(2.0f * x)); }


#define XB_TMO      128
#define XB_XCNT(j)  (256  + 64 * (j))
#define XB_XSUB(j)  (1280 + 64 * (j))
#define XB_XGEN(j)  (2304 + 64 * (j))
#define XB_TOP      3328
#define XB_TOPGEN   3392
#define XCD_BAR_WORDS 3456
#define XB_SPIN_CAP (1u << 22)
__device__ __forceinline__ unsigned xb_ld(unsigned* p)              { return __hip_atomic_load(p, __ATOMIC_RELAXED, __HIP_MEMORY_SCOPE_AGENT); }
__device__ __forceinline__ unsigned xb_add(unsigned* p, unsigned v) { return __hip_atomic_fetch_add(p, v, __ATOMIC_RELAXED, __HIP_MEMORY_SCOPE_AGENT); }
__device__ __forceinline__ unsigned xb_xcc_id() { return (unsigned)__builtin_amdgcn_s_getreg((3 << 11) | 20) & 0xFu; }
#define XB_SPIN(cond, bar) do { unsigned _sp = 0; while (cond) { __builtin_amdgcn_s_sleep(1); \
    if ((++_sp & 255u) == 0u) { if (xb_ld(&(bar)[XB_TMO])) break; if (_sp > XB_SPIN_CAP) { atomicAdd(&(bar)[XB_TMO], 1u); break; } } } } while (0)
struct XcdBarrier { unsigned* bar; unsigned x; volatile LAS unsigned* st; };
__device__ __forceinline__ XcdBarrier xcd_barrier_post(unsigned* bar, volatile LAS unsigned* st) {
    XcdBarrier b; b.bar = bar; b.x = xb_xcc_id(); b.st = st;
    if (threadIdx.x == 0) (void)xb_add(&bar[XB_XCNT(b.x)], 1u);
    return b;
}
__device__ __forceinline__ void xcd_barrier_complete(unsigned* bar, unsigned x, unsigned& nloc, unsigned& nx) {
    const unsigned G = gridDim.x * gridDim.y * gridDim.z;
    unsigned sum, cnt, mine, sp = 0u;
    for (;;) {
        sum = 0u; cnt = 0u; mine = 0u;
#pragma unroll
        for (unsigned j = 0; j < 16; ++j) { const unsigned c = xb_ld(&bar[XB_XCNT(j)]); sum += c; cnt += (c > 0u) ? 1u : 0u; mine = (j == x) ? c : mine; }
        if (sum == G) break;
        __builtin_amdgcn_s_sleep(1);
        if ((++sp & 255u) == 0u) { if (xb_ld(&bar[XB_TMO])) break; if (sp > XB_SPIN_CAP) { atomicAdd(&bar[XB_TMO], 1u); break; } }
    }
    nloc = mine > 0u ? mine : 1u; nx = cnt > 0u ? cnt : 1u;
}
__device__ __forceinline__ void xcd_barrier(const XcdBarrier& b) {
    asm volatile("s_waitcnt vmcnt(0)" ::: "memory");
    __syncthreads();
    if (threadIdx.x == 0) {
        unsigned* bar = b.bar;
        __builtin_amdgcn_s_waitcnt(0);
        unsigned nloc = b.st[0], nx = b.st[1];
        if (nloc == 0u) { xcd_barrier_complete(bar, b.x, nloc, nx); b.st[0] = nloc; b.st[1] = nx; }
        const unsigned old = xb_add(&bar[XB_XSUB(b.x)], 1u);
        const unsigned gen = old / nloc;
        if (old + 1u == (gen + 1u) * nloc) {
            __builtin_amdgcn_fence(__ATOMIC_RELEASE, "agent");
            asm volatile("s_waitcnt vmcnt(0)" ::: "memory");
            const unsigned og = xb_add(&bar[XB_TOP], 1u);
            const unsigned tg = og / nx;
            if (og + 1u == (tg + 1u) * nx) xb_add(&bar[XB_TOPGEN], 1u);
            else XB_SPIN(xb_ld(&bar[XB_TOPGEN]) == tg, bar);
            __builtin_amdgcn_fence(__ATOMIC_ACQUIRE, "agent");
            xb_add(&bar[XB_XGEN(b.x)], 1u);
            asm volatile("s_waitcnt vmcnt(0)" ::: "memory");
        } else {
            XB_SPIN(xb_ld(&bar[XB_XGEN(b.x)]) == gen, bar);
            __builtin_amdgcn_fence(__ATOMIC_ACQUIRE, "agent");
            asm volatile("s_waitcnt vmcnt(0)" ::: "memory");
        }
    }
    __syncthreads();
}

namespace pg8 {
#define PG8_LAS __attribute__((address_space(3)))
typedef unsigned short bf16_t;
typedef unsigned u32x4 __attribute__((ext_vector_type(4)));
constexpr int BM = 256, BK = 64, HALF = 128, HTB = HALF * BK * 2, STAGE_BYTES = 8 * HTB, NXCD = 8, WGM = 8;
__host__ __device__ __forceinline__ int lds_byte(int r, int c) { const int st = (r >> 4) * 2 + (c >> 5), rr = r & 15, cc = c & 31, ob = rr * 64 + cc * 2; return st * 1024 + (ob ^ (((ob >> 9) & 1) << 5)); }
__host__ __device__ __forceinline__ void stage_rc(int b, int& R, int& C) { const int st = b / 1024, sb = b % 1024, swz = sb ^ (((sb >> 9) & 1) << 5); R = (st >> 1) * 16 + swz / 64; C = (st & 1) * 32 + (swz % 64) / 2; }
__host__ __device__ __forceinline__ int perm32(int rho) { const int n = rho >> 4, i = rho & 15; return 8 * (i >> 2) + 4 * n + (i & 3); }

struct Unit { int pm, pn, z; };
struct Gemm { const bf16_t* A; const bf16_t* Bt; int lda, ldb, K; size_t zA, zB; };
struct Order {
    int nM, nN, per, nwg, G, c;
    __device__ void init(int nM_, int nN_, int nZ, int G_, int c_) { nM = nM_; nN = nN_; per = nM * nN; nwg = per * nZ; G = G_; c = c_; }
    __device__ bool next(int i, Unit& u) const {
        const long L = (long)i * G + c; if (L >= nwg) return false;
        u.z = (int)(L / per); int wgid = (int)(L % per);
        { const int q = per / NXCD, r = per % NXCD, xcd = wgid % NXCD, off = wgid / NXCD; wgid = (xcd < r ? xcd * (q + 1) : r * (q + 1) + (xcd - r) * q) + off; }
        const int nig = WGM * nN, gid = wgid / nig, fm = gid * WGM, gsz = (nM - fm) < WGM ? (nM - fm) : WGM;
        u.pm = fm + ((wgid % nig) % gsz); u.pn = (wgid % nig) / gsz; return true;
    }
};
__device__ __forceinline__ unsigned cvt_pk_bf16(float lo, float hi) { unsigned r; asm volatile("v_cvt_pk_bf16_f32 %0, %1, %2" : "=v"(r) : "v"(lo), "v"(hi)); return r; }
__device__ __forceinline__ f32x2 gelu_pk(f32x2 v) {
    const f32x2 av = __builtin_elementwise_abs(v), d = av * 0.2316418882f + 1.0f;
    f32x2 t; t.x = __builtin_amdgcn_rcpf(d.x); t.y = __builtin_amdgcn_rcpf(d.y);
    f32x2 q = t * 0.5307027145f + (-0.7265760135f); q = q * t + 0.7107068705f; q = q * t + (-0.142248368f); q = q * t + 0.127414796f; q = q * t;
    const f32x2 s = (v * v) * (-0.72134752044f);
    f32x2 e; e.x = __builtin_amdgcn_exp2f(s.x); e.y = __builtin_amdgcn_exp2f(s.y);
    const f32x2 m = v * (q * e), r = v - m;
    f32x2 o; o.x = v.x < 0.f ? m.x : r.x; o.y = v.y < 0.f ? m.y : r.y; return o;
}

template <int ACT, int MT = 4> struct EpiBf16 {
    static constexpr bool PERM = true;
    bf16_t* O; int ldc; size_t zstride; int split_cols; size_t split_stride;
    __device__ __forceinline__ void operator()(const f32x4 (&acc)[2][2][MT][2], const Unit& u, int wr, int wc, int fr, int fq) const {
        const int row0 = u.pm * (64 * MT) + wr * (16 * MT) + fr; int colt = u.pn * BM; bf16_t* base = O + (size_t)u.z * zstride;
        if (split_cols) { const int t = colt / split_cols; base += (size_t)t * split_stride; colt -= t * split_cols; }
        const int col0 = colt + wc * 32 + 8 * fq;
#pragma unroll
        for (int ai = 0; ai < 2; ++ai)
#pragma unroll
            for (int m = 0; m < MT; ++m) { bf16_t* rowp = base + (size_t)(row0 + ai * (32 * MT) + m * 16) * ldc + col0;
#pragma unroll
                for (int bj = 0; bj < 2; ++bj) { f32x4 v0 = acc[ai][bj][m][0], v1 = acc[ai][bj][m][1];
                    if (ACT == 1) { f32x2 a = gelu_pk((f32x2){v0[0], v0[1]}), b = gelu_pk((f32x2){v0[2], v0[3]}), c = gelu_pk((f32x2){v1[0], v1[1]}), d = gelu_pk((f32x2){v1[2], v1[3]});
                        v0 = (f32x4){a.x, a.y, b.x, b.y}; v1 = (f32x4){c.x, c.y, d.x, d.y}; }
                    u32x4 w; w.x = cvt_pk_bf16(v0[0], v0[1]); w.y = cvt_pk_bf16(v0[2], v0[3]); w.z = cvt_pk_bf16(v1[0], v1[1]); w.w = cvt_pk_bf16(v1[2], v1[3]);
                    *(u32x4*)(rowp + bj * HALF) = w; } }
    }
};
struct EpiL1 {
    static constexpr bool PERM = true;
    bf16_t* L1;
    __device__ __forceinline__ void operator()(const f32x4 (&acc)[2][2][3][2], const Unit& u, int wr, int wc, int fr, int fq) const {
        const int row0 = u.pm * 192 + wr * 48 + fr, col0 = wc * 32 + 8 * fq, z = u.z;
#pragma unroll
        for (int ai = 0; ai < 2; ++ai)
#pragma unroll
            for (int m = 0; m < 3; ++m) { bf16_t* rowp = L1 + (size_t)(row0 + ai * 96 + m * 16) * 512 + z * 128 + col0;
                f32x4 v0 = acc[ai][0][m][0], v1 = acc[ai][0][m][1];
#pragma unroll
                for (int j = 0; j < 4; ++j) {
                    if (z == 0) { v0[j] = tanhf_(v0[j]); v1[j] = tanhf_(v1[j]); }
                    else if (z == 2) { v0[j] = sigmoidf_(v0[j]); v1[j] = sigmoidf_(v1[j]); } }
                u32x4 w; w.x = cvt_pk_bf16(v0[0], v0[1]); w.y = cvt_pk_bf16(v0[2], v0[3]); w.z = cvt_pk_bf16(v1[0], v1[1]); w.w = cvt_pk_bf16(v1[2], v1[3]);
                *(u32x4*)rowp = w;
                if (z == 2) *(u32x4*)(rowp + 128) = (u32x4){0u, 0u, 0u, 0u}; }
    }
};
__device__ __forceinline__ int cond_row(int m) { return m < MP ? 0 : 1 + ((m - MP) >> 11); }
struct EpiRes {
    static constexpr bool PERM = false;
    const float* xp; const float* xs; float* out; const float* gate;
    __device__ __forceinline__ void operator()(const f32x4 (&acc)[2][2][3][2], const Unit& u, int wr, int wc, int fr, int fq) const {
        const int row0 = u.pm * 192 + wr * 48 + fr, col0 = u.pn * BM + wc * 32 + 4 * fq;
#pragma unroll
        for (int ai = 0; ai < 2; ++ai)
#pragma unroll
            for (int m = 0; m < 3; ++m) { const int row = row0 + ai * 96 + m * 16; const int ci = cond_row(row);
                const float* xin = (row < MP ? xp : xs - (size_t)MP * D) + (size_t)row * D + col0; float* op = out + (size_t)row * D + col0;
#pragma unroll
                for (int bj = 0; bj < 2; ++bj)
#pragma unroll
                    for (int n = 0; n < 2; ++n) { const int co = bj * HALF + n * 16;
                        const f32x4 gv = *(const f32x4*)(gate + ci * 6144 + col0 + co);
                        *(f32x4*)(op + co) = *(const f32x4*)(xin + co) + gv * acc[ai][bj][m][n]; } }
    }
};
struct EpiRes2 {
    static constexpr bool PERM = false;
    const float* xp; const float* xs; float* out; const float* gate; bf16_t* Hn; const float* gn; const float* scn; float* ssq;
    __device__ __forceinline__ void operator()(const f32x4 (&acc)[2][2][3][2], const Unit& u, int wr, int wc, int fr, int fq) const {
        const int row0 = u.pm * 192 + wr * 48 + fr, col0 = u.pn * BM + wc * 32 + 4 * fq;
        f32x4 g4[2][2];
#pragma unroll
        for (int bj = 0; bj < 2; ++bj)
#pragma unroll
            for (int n = 0; n < 2; ++n) g4[bj][n] = *(const f32x4*)(gn + col0 + bj * HALF + n * 16);
#pragma unroll
        for (int ai = 0; ai < 2; ++ai)
#pragma unroll
            for (int m = 0; m < 3; ++m) { const int row = row0 + ai * 96 + m * 16; const int ci = cond_row(row);
                const float* xin = (row < MP ? xp : xs - (size_t)MP * D) + (size_t)row * D + col0; float* op = out + (size_t)row * D + col0; bf16_t* hp = Hn + (size_t)row * D + col0;
                float rs = 0.f;
#pragma unroll
                for (int bj = 0; bj < 2; ++bj)
#pragma unroll
                    for (int n = 0; n < 2; ++n) { const int co = bj * HALF + n * 16;
                        const f32x4 gv = *(const f32x4*)(gate + ci * 6144 + col0 + co);
                        const f32x4 gsn = g4[bj][n] * (*(const f32x4*)(scn + ci * 6144 + col0 + co) + 1.0f);
                        const f32x4 o = *(const f32x4*)(xin + co) + gv * acc[ai][bj][m][n];
                        *(f32x4*)(op + co) = o;
                        rs += (o.x * o.x + o.y * o.y) + (o.z * o.z + o.w * o.w);
                        const f32x4 a = o * gsn; const unsigned w0 = cvt_pk_bf16(a.x, a.y), w1 = cvt_pk_bf16(a.z, a.w);
                        *(v2u*)(hp + co) = (v2u){w0, w1}; }
                rs += __shfl_xor(rs, 16); rs += __shfl_xor(rs, 32);
                if (fq == 0) atomicAdd(ssq + row, rs); }
    }
};
struct EpiResFin {
    static constexpr bool PERM = false;
    const float* xin_; float* out; const float* gate; const float* gfin; float* ssq; unsigned* cnt;
    __device__ __forceinline__ void operator()(f32x4 (&acc)[2][2][3][2], const Unit& u, int wr, int wc, int fr, int fq) const {
        const int row0 = u.pm * 192 + wr * 48 + fr, col0 = u.pn * BM + wc * 32 + 4 * fq;
#pragma unroll
        for (int ai = 0; ai < 2; ++ai)
#pragma unroll
            for (int m = 0; m < 3; ++m) { const int row = row0 + ai * 96 + m * 16; const int ci = cond_row(row);
                const float* xin = xin_ + (size_t)row * D + col0; float rs = 0.f;
#pragma unroll
                for (int bj = 0; bj < 2; ++bj)
#pragma unroll
                    for (int n = 0; n < 2; ++n) { const int co = bj * HALF + n * 16;
                        const f32x4 gv = *(const f32x4*)(gate + ci * 6144 + col0 + co);
                        const f32x4 o = *(const f32x4*)(xin + co) + gv * acc[ai][bj][m][n];
                        acc[ai][bj][m][n] = o;
                        rs += (o.x * o.x + o.y * o.y) + (o.z * o.z + o.w * o.w); }
                rs += __shfl_xor(rs, 16); rs += __shfl_xor(rs, 32);
                if (fq == 0) atomicAdd(ssq + row, rs); }
        asm volatile("s_waitcnt vmcnt(0)" ::: "memory");
        unsigned* cw = cnt + 64 * u.pm;
        if (fr == 0 && fq == 0) __hip_atomic_fetch_add(cw, 1u, __ATOMIC_RELAXED, __HIP_MEMORY_SCOPE_AGENT);
        { unsigned sp = 0;
          while ((unsigned)__builtin_amdgcn_readfirstlane((int)__hip_atomic_load(cw, __ATOMIC_RELAXED, __HIP_MEMORY_SCOPE_AGENT)) < 32u) { __builtin_amdgcn_s_sleep(2); if (++sp > (1u << 22)) break; } }
#pragma unroll
        for (int ai = 0; ai < 2; ++ai)
#pragma unroll
            for (int m = 0; m < 3; ++m) { const int row = row0 + ai * 96 + m * 16;
                const float rstd = rsqrtf(__hip_atomic_load(ssq + row, __ATOMIC_RELAXED, __HIP_MEMORY_SCOPE_AGENT) * (1.0f / D) + 1e-6f);
                float* op = out + (size_t)row * D + col0;
#pragma unroll
                for (int bj = 0; bj < 2; ++bj)
#pragma unroll
                    for (int n = 0; n < 2; ++n) { const int co = bj * HALF + n * 16;
                        *(f32x4*)(op + co) = acc[ai][bj][m][n] * rstd * *(const f32x4*)(gfin + col0 + co); } }
    }
};
template <int ACT> struct EpiBf16R {
    static constexpr bool PERM = true;
    bf16_t* O; int ldc; int split_cols; size_t split_stride; const float* ssq; const float* bias; int nb; float* stat2;
    __device__ __forceinline__ void operator()(const f32x4 (&acc)[2][2][4][2], const Unit& u, int wr, int wc, int fr, int fq) const {
        const int row0 = u.pm * BM + wr * 64 + fr; int colt = u.pn * BM; bf16_t* base = O;
        const bool dostat = stat2 != nullptr && split_cols && colt >= split_cols;
        float st1[2][4], st2[2][4];
#pragma unroll
        for (int ai = 0; ai < 2; ++ai)
#pragma unroll
            for (int m = 0; m < 4; ++m) { st1[ai][m] = 0.f; st2[ai][m] = 0.f; }
        const int ci = u.pm < 16 ? 0 : 1 + ((u.pm - 16) >> 3);
        const int bcol0 = colt + wc * 32 + 8 * fq;
        if (split_cols) { const int t = colt / split_cols; base += (size_t)t * split_stride; colt -= t * split_cols; }
        const int col0 = colt + wc * 32 + 8 * fq;
        float rstd[2][4];
#pragma unroll
        for (int ai = 0; ai < 2; ++ai)
#pragma unroll
            for (int m = 0; m < 4; ++m) rstd[ai][m] = rsqrtf(ssq[row0 + ai * HALF + m * 16] * (1.0f / D) + 1e-6f);
#pragma unroll
        for (int bj = 0; bj < 2; ++bj) {
            const f32x4 b0 = *(const f32x4*)(bias + (size_t)ci * nb + bcol0 + bj * HALF), b1 = *(const f32x4*)(bias + (size_t)ci * nb + bcol0 + bj * HALF + 4);
#pragma unroll
            for (int ai = 0; ai < 2; ++ai)
#pragma unroll
                for (int m = 0; m < 4; ++m) { bf16_t* rowp = base + (size_t)(row0 + ai * HALF + m * 16) * ldc + col0;
                    f32x4 v0 = acc[ai][bj][m][0] * rstd[ai][m] + b0, v1 = acc[ai][bj][m][1] * rstd[ai][m] + b1;
                    if (ACT == 1) { f32x2 a = gelu_pk((f32x2){v0[0], v0[1]}), b = gelu_pk((f32x2){v0[2], v0[3]}), c = gelu_pk((f32x2){v1[0], v1[1]}), d = gelu_pk((f32x2){v1[2], v1[3]});
                        v0 = (f32x4){a.x, a.y, b.x, b.y}; v1 = (f32x4){c.x, c.y, d.x, d.y}; }
                    u32x4 w; w.x = cvt_pk_bf16(v0[0], v0[1]); w.y = cvt_pk_bf16(v0[2], v0[3]); w.z = cvt_pk_bf16(v1[0], v1[1]); w.w = cvt_pk_bf16(v1[2], v1[3]);
                    *(u32x4*)(rowp + bj * HALF) = w;
                    if (ACT == 1 && dostat) { st1[ai][m] += ((v0[0] + v0[1]) + (v0[2] + v0[3])) + ((v1[0] + v1[1]) + (v1[2] + v1[3]));
                        st2[ai][m] += ((v0[0] * v0[0] + v0[1] * v0[1]) + (v0[2] * v0[2] + v0[3] * v0[3])) + ((v1[0] * v1[0] + v1[1] * v1[1]) + (v1[2] * v1[2] + v1[3] * v1[3])); } }
        }
        if (ACT == 1 && dostat) {
#pragma unroll
            for (int ai = 0; ai < 2; ++ai)
#pragma unroll
                for (int m = 0; m < 4; ++m) { float a = st1[ai][m], b = st2[ai][m];
                    a += __shfl_xor(a, 16); a += __shfl_xor(a, 32); b += __shfl_xor(b, 16); b += __shfl_xor(b, 32);
                    if (fq == 0) { float* sp = stat2 + 2 * (size_t)(row0 + ai * HALF + m * 16); atomicAdd(sp, a); atomicAdd(sp + 1, b); } }
        }
    }
};

template <class Epi, int MT = 4>
__device__ __forceinline__ void gemm_phase(PG8_LAS unsigned char* lds, const Gemm g, const Order& S, const Epi& E) {
    const int tid = threadIdx.x, wid = __builtin_amdgcn_readfirstlane(tid >> 6), lane = tid & 63, wr = wid >> 2, wc = wid & 3, fr = lane & 15, fq = lane >> 4;
    const int K = g.K, nt = K / BK;
    unsigned voffA[2], voffB[2];
#pragma unroll
    for (int i = 0; i < 2; ++i) { int R, C; stage_rc(tid * 16 + i * 8192, R, C); const int Rb = Epi::PERM ? ((R & ~31) + perm32(R & 31)) : R;
        voffA[i] = (unsigned)(R * g.lda + C) * 2u; voffB[i] = (unsigned)(Rb * g.ldb + C) * 2u; }
    const size_t kstep = (size_t)(BK * 2);
    const size_t hA = (size_t)(32 * MT) * g.lda * 2, hB = (size_t)HALF * g.ldb * 2, tA = 2 * hA, tB = 2 * hB;
    const unsigned ldsw = (unsigned)wid * 1024u;
    const int aoff = lds_byte(wr * 16 * MT + fr, fq * 8), boff = lds_byte(wc * 32 + fr, fq * 8);
#define PG8_SA(b, h) (((b) * 2 + (h)) * HTB)
#define PG8_SB(b, h) ((4 + (b) * 2 + (h)) * HTB)
#define PG8_STAGE(bufoff, gbase, voff) do { _Pragma("unroll") for (int _i = 0; _i < 2; ++_i) \
        __builtin_amdgcn_global_load_lds((const unsigned*)((const char*)(gbase) + (voff)[_i]), (PG8_LAS unsigned*)(lds + (bufoff) + ldsw + _i * 8192), 16, 0, 0); } while (0)
#define PG8_LDA(dst, b, h) do { _Pragma("unroll") for (int m = 0; m < MT; ++m) _Pragma("unroll") for (int k = 0; k < 2; ++k) dst[m][k] = *(const PG8_LAS bf16x8*)(lds + PG8_SA(b, h) + aoff + m * 2048 + k * 1024); } while (0)
#define PG8_LDB(dst, b, h) do { _Pragma("unroll") for (int n = 0; n < 2; ++n) _Pragma("unroll") for (int k = 0; k < 2; ++k) dst[n][k] = *(const PG8_LAS bf16x8*)(lds + PG8_SB(b, h) + boff + n * 2048 + k * 1024); } while (0)
#define PG8_MMA(ai, bj, At, Bt) do { __builtin_amdgcn_s_setprio(1); _Pragma("unroll") for (int m = 0; m < MT; ++m) _Pragma("unroll") for (int n = 0; n < 2; ++n) _Pragma("unroll") for (int k = 0; k < 2; ++k) \
        acc[ai][bj][m][n] = __builtin_amdgcn_mfma_f32_16x16x32_bf16(Bt[n][k], At[m][k], acc[ai][bj][m][n], 0, 0, 0); __builtin_amdgcn_s_setprio(0); } while (0)
#define PG8_WAIT_V(n) asm volatile("s_waitcnt vmcnt(" #n ")" ::: "memory")
#define PG8_WAIT_L(n) asm volatile("s_waitcnt lgkmcnt(" #n ")" ::: "memory")
#define PG8_BAR __builtin_amdgcn_s_barrier()
#define PG8_SCHED __builtin_amdgcn_sched_barrier(0)
    Unit cur, nxt; int ui = 0;
    if (!S.next(0, cur)) return;
    f32x4 acc[2][2][MT][2];
#pragma unroll
    for (int a = 0; a < 2; ++a)
#pragma unroll
        for (int b = 0; b < 2; ++b)
#pragma unroll
            for (int m = 0; m < MT; ++m)
#pragma unroll
                for (int n = 0; n < 2; ++n) acc[a][b][m][n] = (f32x4){0.f, 0.f, 0.f, 0.f};
    bf16x8 At[MT][2], B0[2][2], B1[2][2];
    const char* cA = (const char*)g.A + (size_t)cur.z * g.zA + (size_t)cur.pm * tA; const char* cB = (const char*)g.Bt + (size_t)cur.z * g.zB + (size_t)cur.pn * tB;
    PG8_STAGE(PG8_SB(0, 0), cB, voffB); PG8_STAGE(PG8_SB(0, 1), cB + hB, voffB); PG8_STAGE(PG8_SA(0, 0), cA, voffA); PG8_STAGE(PG8_SA(0, 1), cA + hA, voffA);
    if (wr == 1) PG8_BAR;
    PG8_WAIT_V(2); PG8_BAR;
    PG8_STAGE(PG8_SB(1, 0), cB + kstep, voffB); PG8_STAGE(PG8_SA(1, 0), cA + kstep, voffA); PG8_STAGE(PG8_SB(1, 1), cB + hB + kstep, voffB);
    PG8_WAIT_V(6); PG8_BAR;
    for (;;) {
        const bool has_next = S.next(ui + 1, nxt);
        const char* nA = has_next ? (const char*)g.A + (size_t)nxt.z * g.zA + (size_t)nxt.pm * tA : cA; const char* nB = has_next ? (const char*)g.Bt + (size_t)nxt.z * g.zB + (size_t)nxt.pn * tB : cB;
        for (int t = 0; t < nt; t += 2) {
            const bool last = (t == nt - 2);
            const char* a1 = cA + (size_t)(t + 1) * kstep;
            const char* a2 = last ? nA : cA + (size_t)(t + 2) * kstep; const char* b2 = last ? nB : cB + (size_t)(t + 2) * kstep;
            const char* a3 = a2 + kstep; const char* b3 = b2 + kstep;
            PG8_LDB(B0, 0, 0); PG8_LDB(B1, 0, 1); PG8_SCHED; PG8_LDA(At, 0, 0); PG8_STAGE(PG8_SA(1, 1), a1 + hA, voffA);
            PG8_WAIT_V(8); PG8_WAIT_L(0); PG8_BAR; PG8_MMA(0, 0, At, B0); PG8_MMA(0, 1, At, B1); PG8_BAR; PG8_SCHED;
            PG8_LDA(At, 0, 1); PG8_STAGE(PG8_SB(0, 0), b2, voffB); PG8_STAGE(PG8_SB(0, 1), b2 + hB, voffB); PG8_STAGE(PG8_SA(0, 0), a2, voffA);
            PG8_WAIT_V(8); PG8_WAIT_L(0); PG8_BAR; PG8_MMA(1, 0, At, B0); PG8_MMA(1, 1, At, B1); PG8_BAR; PG8_SCHED;
            PG8_LDB(B0, 1, 0); PG8_LDB(B1, 1, 1); PG8_SCHED; PG8_LDA(At, 1, 0); PG8_STAGE(PG8_SA(0, 1), a2 + hA, voffA);
            PG8_WAIT_V(8); PG8_WAIT_L(0); PG8_BAR; PG8_MMA(0, 0, At, B0); PG8_MMA(0, 1, At, B1); PG8_BAR; PG8_SCHED;
            PG8_LDA(At, 1, 1); PG8_STAGE(PG8_SB(1, 0), b3, voffB); PG8_STAGE(PG8_SB(1, 1), b3 + hB, voffB); PG8_STAGE(PG8_SA(1, 0), a3, voffA);
            PG8_WAIT_V(8); PG8_WAIT_L(0); PG8_BAR; PG8_MMA(1, 0, At, B0); PG8_MMA(1, 1, At, B1); PG8_BAR; PG8_SCHED;
        }
        if (wr == 0) PG8_BAR;
        E(acc, cur, wr, wc, fr, fq);
        if (!has_next) break;
#pragma unroll
        for (int a = 0; a < 2; ++a)
#pragma unroll
            for (int b = 0; b < 2; ++b)
#pragma unroll
                for (int m = 0; m < MT; ++m)
#pragma unroll
                    for (int n = 0; n < 2; ++n) acc[a][b][m][n] = (f32x4){0.f, 0.f, 0.f, 0.f};
        cur = nxt; cA = nA; cB = nB; ++ui;
        if (wr == 1) PG8_BAR;
    }
    PG8_WAIT_V(0);
    PG8_BAR;
#undef PG8_SA
#undef PG8_SB
#undef PG8_STAGE
#undef PG8_LDA
#undef PG8_LDB
#undef PG8_MMA
#undef PG8_WAIT_V
#undef PG8_WAIT_L
#undef PG8_BAR
#undef PG8_SCHED
}
}

__device__ __forceinline__ int cond_of(int m) { return m < MP ? 0 : 1 + ((m - MP) >> 11); }

__device__ __forceinline__ void transpose_item(const float* W, int K, int N, bf16* WT, int ldk, int row_off, LAS float* scr, int item, int lane) {
    const int nblk = N / 64, kb = item / nblk, nb = item % nblk, k0 = 64 * kb, n0 = 64 * nb;
    const float* src = W + (size_t)k0 * N + n0 + lane;
#pragma unroll 16
    for (int i = 0; i < 64; ++i) scr[i * 65 + lane] = src[(size_t)i * N];
    LDS_WAIT();
    const int c = lane & 7;
#pragma unroll
    for (int j = 0; j < 8; ++j) { const int n = (lane >> 3) + 8 * j; const LAS float* t = scr + (8 * c) * 65 + n;
        v4u o; o.x = pk2(t[0 * 65], t[1 * 65]); o.y = pk2(t[2 * 65], t[3 * 65]); o.z = pk2(t[4 * 65], t[5 * 65]); o.w = pk2(t[6 * 65], t[7 * 65]);
        *(v4u*)(WT + (size_t)(row_off + n0 + n) * ldk + k0 + 8 * c) = o; }
    LDS_WAIT();
}
#define TR_JOB(W_, K_, N_, WT_, LD_, RO_) { const int ni = ((K_) / 64) * ((N_) / 64); if (r < ni) { transpose_item((W_), (K_), (N_), (WT_), (LD_), (RO_), scr, r, lane); continue; } r -= ni; }

__device__ __forceinline__ void phase_mod(const Params& p, unsigned char* lds) {
    float* sc = (float*)lds;
    float* red = sc + 5 * 1024;
    const int tid = threadIdx.x;
    if ((int)blockIdx.x < 192) {
        for (int i = tid; i < 5 * 1024; i += 512) { const int ci = i >> 10, k = i & 1023; const float x = ci == 0 ? p.in[5][k] : p.in[4][(ci - 1) * 1024 + k]; sc[i] = x / (1.0f + __expf(-x)); }
    }
    __syncthreads();
    float* MOD = (float*)(p.ws + OFF_MOD);
    for (int it = blockIdx.x; it < 192; it += gridDim.x) {
        const int layer = it / 96, n0 = (it % 96) * 64, ks = tid >> 6, nl = tid & 63;
        const float* W = p.in[6] + (size_t)layer * 1024 * 6144 + n0 + nl;
        float a0 = 0.f, a1 = 0.f, a2 = 0.f, a3 = 0.f, a4 = 0.f;
#pragma unroll 8
        for (int k = ks * 128; k < ks * 128 + 128; ++k) { const float w = W[(size_t)k * 6144];
            a0 += sc[k] * w; a1 += sc[1024 + k] * w; a2 += sc[2048 + k] * w; a3 += sc[3072 + k] * w; a4 += sc[4096 + k] * w; }
        red[(ks * 5 + 0) * 64 + nl] = a0; red[(ks * 5 + 1) * 64 + nl] = a1; red[(ks * 5 + 2) * 64 + nl] = a2; red[(ks * 5 + 3) * 64 + nl] = a3; red[(ks * 5 + 4) * 64 + nl] = a4;
        __syncthreads();
        if (tid < 320) { const int ci = tid >> 6; float s = p.in[7][layer * 6144 + n0 + nl];
#pragma unroll
            for (int q = 0; q < 8; ++q) s += red[(q * 5 + ci) * 64 + nl];
            MOD[(layer * 5 + ci) * 6144 + n0 + nl] = s; }
        __syncthreads();
    }
}
__device__ __forceinline__ void phase_w0(const Params& p, unsigned char* lds) {
    const int tid = threadIdx.x, lane = tid & 63, wave = tid >> 6;
    LAS float* scr = (LAS float*)((LAS unsigned char*)lds) + wave * (64 * 65);
    const int gw = blockIdx.x * 8 + wave, NGW = gridDim.x * 8;
    unsigned char* WB = p.ws + OFF_W;
    bf16* wrkv = (bf16*)(WB + W_RKV); bf16* wo = (bf16*)(WB + W_O); bf16* wl1 = (bf16*)(WB + W_L1); bf16* g2t = (bf16*)(WB + W_G2);
    bf16* w2t = (bf16*)(WB + W_W2); bf16* a2t = (bf16*)(WB + W_A2); bf16* upt = (bf16*)(WB + W_UP); bf16* dnt = (bf16*)(WB + W_DN);
    constexpr int NITEMS = 3 * 256 + 4 * 16 + 32 + 32 + 4 * 16;
    for (int it = gw; it < NITEMS; it += NGW) {
        int r = it;
        TR_JOB(p.in[16], 1024, 1024, wrkv, 1024, 0)
        TR_JOB(p.in[17], 1024, 1024, wrkv, 1024, 1024)
        TR_JOB(p.in[18], 1024, 1024, wrkv, 1024, 2048)
        TR_JOB(p.in[21], 1024, 64, wl1, 1024, 0)
        TR_JOB(p.in[21] + 1024 * 64, 1024, 64, wl1, 1024, 64)
        TR_JOB(p.in[24], 1024, 64, wl1 + 256 * 1024, 1024, 0)
        TR_JOB(p.in[24] + 1024 * 64, 1024, 64, wl1 + 256 * 1024, 1024, 64)
        TR_JOB(p.in[26], 1024, 128, wl1 + 512 * 1024, 1024, 0)
        TR_JOB(p.in[27], 128, 1024, g2t, 256, 0)
        TR_JOB(p.in[22], 64, 1024, w2t, 64, 0)
        TR_JOB(p.in[22] + 64 * 1024, 64, 1024, w2t + 1024 * 64, 64, 0)
        TR_JOB(p.in[25], 64, 1024, a2t, 64, 0)
        TR_JOB(p.in[25] + 64 * 1024, 64, 1024, a2t + 1024 * 64, 64, 0)
    }
    const int gt = blockIdx.x * 512 + tid, GT = gridDim.x * 512;
    for (int i = gt; i < 3 * 128 * 128; i += GT) { const int z = i / (128 * 128), rr = (i / 128) % 128, c = i % 128; *(v4u*)(wl1 + (size_t)(z * 256 + 128 + rr) * 1024 + c * 8) = (v4u){0u, 0u, 0u, 0u}; }
    for (int i = gt; i < 1024 * 16; i += GT) { const int rr = i / 16, c = i % 16; *(v4u*)(g2t + (size_t)rr * 256 + 128 + c * 8) = (v4u){0u, 0u, 0u, 0u}; }
    for (int i = gt; i < (4 * M + 64 * 64) / 4; i += GT) *(f32x4*)((float*)(p.ws + OFF_SSQ) + 4 * i) = (f32x4){0.f, 0.f, 0.f, 0.f};
}
__device__ __forceinline__ void phase_bias(const Params& p, unsigned char* lds, int wi, int nw) {
    float* sc = (float*)lds;
    float* red = sc + 5 * 1024;
    const int tid = threadIdx.x;
    const float* MOD = (const float*)(p.ws + OFF_MOD);
    int cur = -1;
    for (int it = wi; it < 88 + 64 + 88; it += nw) {
        const int which = it < 88 ? 0 : (it < 152 ? 1 : 2);
        const int blk = which == 0 ? it : (which == 1 ? it - 88 : it - 152);
        const int N = which == 1 ? 4096 : F2;
        const float* Wsrc = which == 0 ? p.in[10] : (which == 1 ? p.in[33] : p.in[10] + (size_t)1024 * F2);
        const float* shv = MOD + (which == 0 ? 3 * 1024 : (which == 1 ? 5 * 6144 : 5 * 6144 + 3 * 1024));
        float* outb = (float*)(p.ws + (which == 0 ? BIAS0 : (which == 1 ? BIAS1 : BIAS2)));
        if (which != cur) { __syncthreads(); for (int i = tid; i < 5 * 1024; i += 512) sc[i] = shv[(i >> 10) * 6144 + (i & 1023)]; cur = which; __syncthreads(); }
        const int n0 = blk * 64, ks = tid >> 6, nl = tid & 63;
        const float* W = Wsrc + n0 + nl;
        float a0 = 0.f, a1 = 0.f, a2 = 0.f, a3 = 0.f, a4 = 0.f;
#pragma unroll 32
        for (int k = ks * 128; k < ks * 128 + 128; ++k) { const float w = W[(size_t)k * N];
            a0 += sc[k] * w; a1 += sc[1024 + k] * w; a2 += sc[2048 + k] * w; a3 += sc[3072 + k] * w; a4 += sc[4096 + k] * w; }
        red[(ks * 5 + 0) * 64 + nl] = a0; red[(ks * 5 + 1) * 64 + nl] = a1; red[(ks * 5 + 2) * 64 + nl] = a2; red[(ks * 5 + 3) * 64 + nl] = a3; red[(ks * 5 + 4) * 64 + nl] = a4;
        __syncthreads();
        if (tid < 320) { const int ci = tid >> 6; float sum = 0.f;
#pragma unroll
            for (int q = 0; q < 8; ++q) sum += red[(q * 5 + ci) * 64 + nl];
            outb[(size_t)ci * N + n0 + nl] = sum; }
        __syncthreads();
    }
}
__device__ __forceinline__ void phase_w1(const Params& p, unsigned char* lds) {
    const int tid = threadIdx.x, lane = tid & 63, wave = tid >> 6;
    LAS float* scr = (LAS float*)((LAS unsigned char*)lds) + wave * (64 * 65);
    const int gw = blockIdx.x * 8 + wave, NGW = gridDim.x * 8;
    bf16* dnt = (bf16*)(p.ws + OFF_W + W1_DN);
    constexpr int NITEMS = 44 * 16;
    for (int it = gw; it < NITEMS; it += NGW) {
        int r = it;
        TR_JOB(p.in[13] + (size_t)FH * 1024, FH, 1024, dnt, FH, 0)
    }
}
__device__ __forceinline__ void phase_wlate(const Params& p, unsigned char* lds, int wi, int nw) {
    const int tid = threadIdx.x, lane = tid & 63, wave = tid >> 6;
    LAS float* scr = (LAS float*)((LAS unsigned char*)lds) + wave * (64 * 65);
    const int gw = wi * 8 + wave, NGW = nw * 8;
    unsigned char* WB = p.ws + OFF_W;
    bf16* wo = (bf16*)(WB + W_O); bf16* upt = (bf16*)(WB + W_UP); bf16* dnt = (bf16*)(WB + W_DN);
    bf16* sgin = (bf16*)(p.ws + X_SGIN); bf16* sgout = (bf16*)(p.ws + X_SGOUT); bf16* up1 = (bf16*)(p.ws + X_UP1); bf16* wsb = (bf16*)(p.ws + X_WS);
    constexpr int NITEMS = 256 + 16 * 88 + 44 * 16 + 16 * 64 + 32 * 16 + 16 * 88 + 44 * 16;
    for (int it = gw; it < NITEMS; it += NGW) {
        int r = it;
        TR_JOB(p.in[19], 1024, 1024, wo, 1024, 0)
        TR_JOB(p.in[10], 1024, F2, upt, 1024, 0)
        TR_JOB(p.in[13], FH, 1024, dnt, FH, 0)
        TR_JOB(p.in[33], 1024, 4096, sgin, 1024, 0)
        TR_JOB(p.in[38], E, 1024, sgout, E, 0)
        TR_JOB(p.in[10] + (size_t)1024 * F2, 1024, F2, up1, 1024, 0)
        TR_JOB(p.in[13] + (size_t)FH * 1024, FH, 1024, (bf16*)(WB + W_RKV), FH, 0)
    }
    const int gt = wi * 512 + tid, GT = nw * 512;
    for (int i = gt; i < 8 * 128 * 128 / 4; i += GT) { const f32x4 v = *(const f32x4*)(p.in[36] + (size_t)i * 4); *(v2u*)(wsb + (size_t)i * 4) = pack4(v); }
}

__device__ __forceinline__ const float* xrow_l0(const Params& p, int m) { return m < MP ? p.in[0] + (size_t)m * D : p.in[1] + (size_t)(m - MP) * D; }

__device__ __forceinline__ void phase_mix(const Params& p) {
    const int tid = threadIdx.x, lane = tid & 63, wave = tid >> 6;
    const int gw = blockIdx.x * 8 + wave, NGW = gridDim.x * 8;
    const float* MOD = (const float*)(p.ws + OFF_MOD);
    unsigned char* AB = p.ws + OFF_A;
    for (int m = gw; m < M; m += NGW) {
        const int T = m < MP ? 256 : 2048, t = m < MP ? (m & 255) : ((m - MP) & 2047), ci = cond_of(m);
        const bool okp = t > 0, okn = t < T - 1;
        const f32x4* x1 = (const f32x4*)xrow_l0(p, m) + 2 * lane;
        const f32x4* x0 = (const f32x4*)xrow_l0(p, okp ? m - 1 : m) + 2 * lane;
        const f32x4* x2 = (const f32x4*)xrow_l0(p, okn ? m + 1 : m) + 2 * lane;
        f32x4 a[4], b[4], c[4]; float s0 = 0.f, s1 = 0.f, s2 = 0.f;
#pragma unroll
        for (int j = 0; j < 4; ++j) { const int o = (j >> 1) * 128 + (j & 1); a[j] = x0[o]; b[j] = x1[o]; c[j] = x2[o];
            s0 += (a[j].x * a[j].x + a[j].y * a[j].y) + (a[j].z * a[j].z + a[j].w * a[j].w);
            s1 += (b[j].x * b[j].x + b[j].y * b[j].y) + (b[j].z * b[j].z + b[j].w * b[j].w);
            s2 += (c[j].x * c[j].x + c[j].y * c[j].y) + (c[j].z * c[j].z + c[j].w * c[j].w); }
        const float r0 = okp ? rsqrtf(wave_sum(s0) * (1.f / D) + 1e-6f) : 0.f, r1 = rsqrtf(wave_sum(s1) * (1.f / D) + 1e-6f), r2 = okn ? rsqrtf(wave_sum(s2) * (1.f / D) + 1e-6f) : 0.f;
        const float* sh = MOD + ci * 6144; const float* scp = sh + 1024;
        f32x4 h1[4], dp[4], dn[4];
#pragma unroll
        for (int j = 0; j < 4; ++j) {
            const int col = (j >> 1) * 512 + 8 * lane + (j & 1) * 4;
            const f32x4 g = *(const f32x4*)(p.in[8] + col), sc1 = *(const f32x4*)(scp + col), sh1 = *(const f32x4*)(sh + col);
            const f32x4 gs = g * (sc1 + 1.0f);
            f32x4 h0 = a[j] * r0 * gs + sh1, h2 = c[j] * r2 * gs + sh1; h1[j] = b[j] * r1 * gs + sh1;
            if (!okp) h0 = (f32x4){0.f, 0.f, 0.f, 0.f};
            if (!okn) h2 = (f32x4){0.f, 0.f, 0.f, 0.f};
            dp[j] = h0 - h1[j]; dn[j] = h2 - h1[j];
        }
#pragma unroll
        for (int q = 0; q < 2; ++q) {
            const int col = q * 512 + 8 * lane;
#pragma unroll
            for (int i = 0; i < 6; ++i) {
                const int slot = i == 0 ? 3 : i == 1 ? 0 : i == 2 ? 4 : i == 3 ? 5 : i == 4 ? 1 : 2;
                const float* m0p = p.in[15] + i * 1024 + col; const float* m1p = p.in[15] + (6 + i) * 1024 + col;
                const f32x4 oa = h1[2 * q] + dp[2 * q] * *(const f32x4*)m0p + dn[2 * q] * *(const f32x4*)m1p;
                const f32x4 ob = h1[2 * q + 1] + dp[2 * q + 1] * *(const f32x4*)(m0p + 4) + dn[2 * q + 1] * *(const f32x4*)(m1p + 4);
                v4u w; w.x = pk2(oa.x, oa.y); w.y = pk2(oa.z, oa.w); w.z = pk2(ob.x, ob.y); w.w = pk2(ob.z, ob.w);
                *(v4u*)((bf16*)(AB + slot * SL) + (size_t)m * D + col) = w;
            }
        }
    }
}
__device__ __forceinline__ void phase_norm(const Params& p, const float* gvec, int layer, int shofs, int scofs) {
    const int tid = threadIdx.x, lane = tid & 63, wave = tid >> 6;
    const int gw = blockIdx.x * 8 + wave, NGW = gridDim.x * 8;
    const float* MOD = (const float*)(p.ws + OFF_MOD) + layer * 5 * 6144;
    bf16* H = (bf16*)(p.ws + OFF_A + A_H);
    for (int m = gw; m < M; m += 3 * NGW) {
        f32x4 b[3][4];
#pragma unroll
        for (int k = 0; k < 3; ++k) { const int mm = (m + k * NGW < M) ? m + k * NGW : m; const f32x4* x1 = (const f32x4*)(p.out + (size_t)mm * D) + lane;
#pragma unroll
            for (int j = 0; j < 4; ++j) b[k][j] = x1[64 * j]; }
#pragma unroll
        for (int k = 0; k < 3; ++k) { const int mm = m + k * NGW; if (mm >= M) break;
            const int ci = cond_of(mm); float s1 = 0.f;
#pragma unroll
            for (int j = 0; j < 4; ++j) s1 += (b[k][j].x * b[k][j].x + b[k][j].y * b[k][j].y) + (b[k][j].z * b[k][j].z + b[k][j].w * b[k][j].w);
            const float r1 = rsqrtf(wave_sum(s1) * (1.f / D) + 1e-6f);
#pragma unroll
            for (int j = 0; j < 4; ++j) {
                const int col = 4 * lane + 256 * j;
                const f32x4 g = *(const f32x4*)(gvec + col), sc = *(const f32x4*)(MOD + ci * 6144 + scofs + col), sh = *(const f32x4*)(MOD + ci * 6144 + shofs + col);
                const f32x4 h = b[k][j] * r1 * g * (sc + 1.0f) + sh;
                *(v2u*)(H + (size_t)mm * D + col) = pack4(h);
            } }
    }
}
__device__ __forceinline__ void phase_final(const Params& p) {
    const int tid = threadIdx.x, lane = tid & 63, wave = tid >> 6;
    const int gw = blockIdx.x * 8 + wave, NGW = gridDim.x * 8;
    for (int m = gw; m < M; m += 3 * NGW) {
        f32x4 b[3][4];
#pragma unroll
        for (int k = 0; k < 3; ++k) { const int mm = (m + k * NGW < M) ? m + k * NGW : m; const f32x4* x1 = (const f32x4*)(p.out + (size_t)mm * D) + lane;
#pragma unroll
            for (int j = 0; j < 4; ++j) b[k][j] = x1[64 * j]; }
#pragma unroll
        for (int k = 0; k < 3; ++k) { const int mm = m + k * NGW; if (mm >= M) break;
            float s1 = 0.f;
#pragma unroll
            for (int j = 0; j < 4; ++j) s1 += (b[k][j].x * b[k][j].x + b[k][j].y * b[k][j].y) + (b[k][j].z * b[k][j].z + b[k][j].w * b[k][j].w);
            const float r1 = rsqrtf(wave_sum(s1) * (1.f / D) + 1e-6f);
            f32x4* xo = (f32x4*)(p.out + (size_t)mm * D) + lane;
#pragma unroll
            for (int j = 0; j < 4; ++j) { const f32x4 g = *(const f32x4*)(p.in[14] + 4 * lane + 256 * j); xo[64 * j] = b[k][j] * r1 * g; } }
    }
}

constexpr int VST = 324;
constexpr int TC = 32;
constexpr int SBUF = TC * VST + TC * 64;
#define LO2(v) __builtin_shufflevector(v, v, 0, 1)
#define HI2(v) __builtin_shufflevector(v, v, 2, 3)
__device__ __forceinline__ void scan_prep(const Params& p, float* buf, int mrow0, int tile, int h, int d, int lane) {
    const int fr = lane & 15, fq = lane >> 4;
    unsigned char* AB = p.ws + OFF_A;
    const bf16* Rb = (const bf16*)(AB + 0 * SL); const bf16* Kb = (const bf16*)(AB + 1 * SL); const bf16* Vb = (const bf16*)(AB + 2 * SL);
    const bf16* L1 = (const bf16*)(AB + A_L1);
    const bf16* W2T = (const bf16*)(p.ws + OFF_W + W_W2); const bf16* A2T = (const bf16*)(p.ws + OFF_W + W_A2);
    float* BONd = (float*)(p.ws + OFF_BON) + (size_t)d * M * 16;
    float* VEC = buf; float* VV = buf + TC * VST;
    const int tl = 16 * tile + fr; const size_t m = (size_t)(mrow0 + tl);
    const bf16* l1row = L1 + m * 512 + d * 64;
    const bf16x8 yw0 = *(const bf16x8*)(l1row + 8 * fq), yw1 = *(const bf16x8*)(l1row + 32 + 8 * fq);
    const bf16x8 ya0 = *(const bf16x8*)(l1row + 128 + 8 * fq), ya1 = *(const bf16x8*)(l1row + 160 + 8 * fq);
    f32x4 dec[4], asg[4], kkr[4], kd[4], rr[4];
    float ss = 0.f, bon = 0.f;
#pragma unroll
    for (int nt = 0; nt < 4; ++nt) {
        const size_t wro = ((size_t)(d * 1024 + h * 64 + nt * 16 + fr)) * 64;
        const bf16x8 xw0 = *(const bf16x8*)(W2T + wro + 8 * fq), xw1 = *(const bf16x8*)(W2T + wro + 32 + 8 * fq);
        const bf16x8 xa0 = *(const bf16x8*)(A2T + wro + 8 * fq), xa1 = *(const bf16x8*)(A2T + wro + 32 + 8 * fq);
        f32x4 aw = (f32x4){0.f, 0.f, 0.f, 0.f}, aa = (f32x4){0.f, 0.f, 0.f, 0.f};
        aw = __builtin_amdgcn_mfma_f32_16x16x32_bf16(xw0, yw0, aw, 0, 0, 0); aw = __builtin_amdgcn_mfma_f32_16x16x32_bf16(xw1, yw1, aw, 0, 0, 0);
        aa = __builtin_amdgcn_mfma_f32_16x16x32_bf16(xa0, ya0, aa, 0, 0, 0); aa = __builtin_amdgcn_mfma_f32_16x16x32_bf16(xa1, ya1, aa, 0, 0, 0);
        const int hjg = h * 64 + nt * 16 + 4 * fq;
        const f32x4 kv = unpack4(*(const v2u*)(Kb + m * D + hjg)), rv = unpack4(*(const v2u*)(Rb + m * D + hjg)), vv = unpack4(*(const v2u*)(Vb + m * D + hjg));
        const f32x4 w0 = *(const f32x4*)(p.in[20] + d * 1024 + hjg), a0 = *(const f32x4*)(p.in[23] + d * 1024 + hjg);
        const f32x4 k_k = *(const f32x4*)(p.in[28] + hjg), k_a = *(const f32x4*)(p.in[29] + hjg), r_k = *(const f32x4*)(p.in[30] + hjg);
#pragma unroll
        for (int j = 0; j < 4; ++j) {
            const float wr_ = aw[j] + w0[j];
            dec[nt][j] = __expf(-0.6065306597126334f * __builtin_amdgcn_rcpf(1.0f + __expf(-wr_)));
            const float as_ = __builtin_amdgcn_rcpf(1.0f + __expf(-(aa[j] + a0[j])));
            asg[nt][j] = as_;
            const float kr = kv[j] * k_k[j]; kkr[nt][j] = kr; ss += kr * kr;
            const float kd_ = kv[j] * (1.0f + (as_ - 1.0f) * k_a[j]); kd[nt][j] = kd_;
            bon += rv[j] * kd_ * r_k[j];
        }
        rr[nt] = rv;
        *(f32x4*)(VV + tl * 64 + nt * 16 + 4 * fq) = vv;
    }
    ss += __shfl_xor(ss, 16); ss += __shfl_xor(ss, 32);
    bon += __shfl_xor(bon, 16); bon += __shfl_xor(bon, 32);
    const float inv = 1.0f / fmaxf(sqrtf(ss), 1e-12f);
    float* vrow = VEC + tl * VST;
#pragma unroll
    for (int nt = 0; nt < 4; ++nt) {
        const int jj = nt * 16 + 4 * fq;
        const f32x4 kk = kkr[nt] * inv;
        *(f32x4*)(vrow + jj) = dec[nt];
        *(f32x4*)(vrow + 64 + jj) = kd[nt];
        *(f32x4*)(vrow + 128 + jj) = -kk;
        *(f32x4*)(vrow + 192 + jj) = kk * asg[nt];
        *(f32x4*)(vrow + 256 + jj) = rr[nt];
    }
    if (fq == 0) BONd[m * 16 + h] = bon;
}
#define SC_LOADV(X, tl_) { const float* vp_ = VEC + (tl_) * VST + j0; \
    X##w0 = *(const f32x4*)(vp_); X##w1 = *(const f32x4*)(vp_ + 4); X##k0 = *(const f32x4*)(vp_ + 64); X##k1 = *(const f32x4*)(vp_ + 68); \
    X##a0 = *(const f32x4*)(vp_ + 128); X##a1 = *(const f32x4*)(vp_ + 132); X##b0 = *(const f32x4*)(vp_ + 192); X##b1 = *(const f32x4*)(vp_ + 196); \
    X##r0 = *(const f32x4*)(vp_ + 256); X##r1 = *(const f32x4*)(vp_ + 260); X##v = *(const f32x2*)(VV + (tl_) * 64 + i0); }
#define SC_STEP(X, tl_) { \
    f32x2 p0_ = S0[0] * LO2(X##a0), p1_ = S1[0] * LO2(X##a0); \
    p0_ = __builtin_elementwise_fma(S0[1], HI2(X##a0), p0_); p1_ = __builtin_elementwise_fma(S1[1], HI2(X##a0), p1_); \
    p0_ = __builtin_elementwise_fma(S0[2], LO2(X##a1), p0_); p1_ = __builtin_elementwise_fma(S1[2], LO2(X##a1), p1_); \
    p0_ = __builtin_elementwise_fma(S0[3], HI2(X##a1), p0_); p1_ = __builtin_elementwise_fma(S1[3], HI2(X##a1), p1_); \
    const f32x2 v0v_ = (f32x2){X##v.x, X##v.x}, v1v_ = (f32x2){X##v.y, X##v.y}; \
    f32x2 t00_ = __builtin_elementwise_fma(v0v_, LO2(X##k0), S0[0] * LO2(X##w0)), t01_ = __builtin_elementwise_fma(v0v_, HI2(X##k0), S0[1] * HI2(X##w0)); \
    f32x2 t02_ = __builtin_elementwise_fma(v0v_, LO2(X##k1), S0[2] * LO2(X##w1)), t03_ = __builtin_elementwise_fma(v0v_, HI2(X##k1), S0[3] * HI2(X##w1)); \
    f32x2 t10_ = __builtin_elementwise_fma(v1v_, LO2(X##k0), S1[0] * LO2(X##w0)), t11_ = __builtin_elementwise_fma(v1v_, HI2(X##k0), S1[1] * HI2(X##w0)); \
    f32x2 t12_ = __builtin_elementwise_fma(v1v_, LO2(X##k1), S1[2] * LO2(X##w1)), t13_ = __builtin_elementwise_fma(v1v_, HI2(X##k1), S1[3] * HI2(X##w1)); \
    const float sa0_ = red8s(p0_.x + p0_.y), sa1_ = red8s(p1_.x + p1_.y); \
    const f32x2 sa0v_ = (f32x2){sa0_, sa0_}, sa1v_ = (f32x2){sa1_, sa1_}; \
    S0[0] = __builtin_elementwise_fma(sa0v_, LO2(X##b0), t00_); S0[1] = __builtin_elementwise_fma(sa0v_, HI2(X##b0), t01_); \
    S0[2] = __builtin_elementwise_fma(sa0v_, LO2(X##b1), t02_); S0[3] = __builtin_elementwise_fma(sa0v_, HI2(X##b1), t03_); \
    S1[0] = __builtin_elementwise_fma(sa1v_, LO2(X##b0), t10_); S1[1] = __builtin_elementwise_fma(sa1v_, HI2(X##b0), t11_); \
    S1[2] = __builtin_elementwise_fma(sa1v_, LO2(X##b1), t12_); S1[3] = __builtin_elementwise_fma(sa1v_, HI2(X##b1), t13_); \
    f32x2 y0_ = S0[0] * LO2(X##r0), y1_ = S1[0] * LO2(X##r0); \
    y0_ = __builtin_elementwise_fma(S0[1], HI2(X##r0), y0_); y1_ = __builtin_elementwise_fma(S1[1], HI2(X##r0), y1_); \
    y0_ = __builtin_elementwise_fma(S0[2], LO2(X##r1), y0_); y1_ = __builtin_elementwise_fma(S1[2], LO2(X##r1), y1_); \
    y0_ = __builtin_elementwise_fma(S0[3], HI2(X##r1), y0_); y1_ = __builtin_elementwise_fma(S1[3], HI2(X##r1), y1_); \
    const float yy0_ = red8s(y0_.x + y0_.y), yy1_ = red8s(y1_.x + y1_.y); \
    *(unsigned*)(Yrow + (size_t)(tl_) * D) = pg8::cvt_pk_bf16(yy0_, yy1_); }

__device__ __forceinline__ void scan_unit(const Params& p, unsigned char* lds, int u) {
    const int tid = threadIdx.x, lane = tid & 63, wave = __builtin_amdgcn_readfirstlane(tid >> 6);
    int b, h, d, T, m0;
    if (u < 128) { b = u >> 5; h = (u >> 1) & 15; d = u & 1; T = 2048; m0 = MP + b * 2048; }
    else { const int v = u - 128; b = v >> 5; h = (v >> 1) & 15; d = v & 1; T = 256; m0 = b * 256; }
    float* BUF = (float*)lds;
    bf16* Yd = (bf16*)(p.ws + OFF_A + (3 + d) * SL);
    const int rp = lane >> 3, cgp = lane & 7, i0 = 16 * wave + 2 * rp, j0 = 8 * cgp;
    f32x2 S0[4], S1[4];
#pragma unroll
    for (int q = 0; q < 4; ++q) { S0[q] = (f32x2){0.f, 0.f}; S1[q] = (f32x2){0.f, 0.f}; }
    if (wave < 4 && u < 128) {
        const float* s0 = (d ? p.in[3] : p.in[2]) + (size_t)(b * 16 + h) * 4096 + (size_t)i0 * 64 + j0;
#pragma unroll
        for (int q = 0; q < 4; ++q) { S0[q] = *(const f32x2*)(s0 + 2 * q); S1[q] = *(const f32x2*)(s0 + 64 + 2 * q); }
    }
    const int nch = T / TC;
    if (wave == 4 || wave == 5) scan_prep(p, BUF, m0 + (d ? nch - 1 : 0) * TC, wave - 4, h, d, lane);
    __syncthreads();
    for (int ch = 0; ch < nch; ++ch) {
        const int tb = (d ? nch - 1 - ch : ch) * TC;
        if (wave < 4) {
            const float* VEC = BUF + (ch & 1) * SBUF; const float* VV = VEC + TC * VST;
            bf16* Yrow = Yd + (size_t)(m0 + tb) * D + h * 64 + i0;
            int tl = d ? TC - 1 : 0; const int dt = d ? -1 : 1;
            f32x4 Aw0, Aw1, Ak0, Ak1, Aa0, Aa1, Ab0, Ab1, Ar0, Ar1; f32x2 Av;
            f32x4 Bw0, Bw1, Bk0, Bk1, Ba0, Ba1, Bb0, Bb1, Br0, Br1; f32x2 Bv;
            SC_LOADV(A, tl)
#pragma unroll 1
            for (int s = 0; s < TC; s += 2) {
                SC_LOADV(B, tl + dt)
                SC_STEP(A, tl)
                const int t2 = (s + 2 < TC) ? tl + 2 * dt : tl + dt;
                SC_LOADV(A, t2)
                SC_STEP(B, tl + dt)
                tl += 2 * dt;
            }
        } else if ((wave == 4 || wave == 5) && ch + 1 < nch) {
            scan_prep(p, BUF + ((ch + 1) & 1) * SBUF, m0 + (d ? nch - 2 - ch : ch + 1) * TC, wave - 4, h, d, lane);
        }
        __syncthreads();
    }
    if (wave < 4 && u >= 128) {
        float* so = p.out + (size_t)M * D + (size_t)d * (16 * 16 * 4096) + (size_t)(b * 16 + h) * 4096 + (size_t)i0 * 64 + j0;
#pragma unroll
        for (int q = 0; q < 4; ++q) { *(f32x2*)(so + 2 * q) = S0[q]; *(f32x2*)(so + 64 + 2 * q) = S1[q]; }
    }
}
__device__ __forceinline__ void phase_scan(const Params& p, unsigned char* lds) {
    const int c = blockIdx.x, G = gridDim.x;
    int u0, nu, ust, wi, nw; bool late;
    if (G == 256) { if (c < 128) { u0 = c; nu = 1; ust = 1; late = false; wi = 0; nw = 1; } else { u0 = 128 + (c - 128) * 4; nu = 4; ust = 1; late = true; wi = c - 128; nw = 128; } }
    else { u0 = c; ust = G; nu = (640 - c + G - 1) / G; late = true; wi = c; nw = G; }
#pragma unroll 1
    for (int k = 0; k < nu; ++k) scan_unit(p, lds, u0 + k * ust);
    if (late) {
        __syncthreads(); phase_wlate(p, lds, wi, nw);
        __syncthreads(); phase_bias(p, lds, wi, nw);
        __syncthreads();
        unsigned char* AB = p.ws + OFF_A; unsigned char* WB = p.ws + OFF_W;
        pg8::Gemm g{(const bf16*)(AB + A_L1) + 256, (const bf16*)(WB + W_G2), 512, 256, 256, 0, 0};
        pg8::Order S; S.init(M / 192, 4, 1, nw, wi);
        pg8::EpiBf16<0, 3> Ep{(bf16*)(AB + A_G), D, 0, 0, 0};
        pg8::gemm_phase<pg8::EpiBf16<0, 3>, 3>((PG8_LAS unsigned char*)lds, g, S, Ep);
    }
}
__device__ __forceinline__ void phase_post(const Params& p) {
    const int tid = threadIdx.x, lane = tid & 63, wave = tid >> 6;
    const int gw = blockIdx.x * 8 + wave, NGW = gridDim.x * 8;
    unsigned char* AB = p.ws + OFF_A;
    const bf16* Vb = (const bf16*)(AB + 2 * SL); const bf16* Y0 = (const bf16*)(AB + 3 * SL); const bf16* Y1 = (const bf16*)(AB + 4 * SL); const bf16* Gb = (const bf16*)(AB + A_G);
    bf16* Z = (bf16*)(AB + 5 * SL);
    const float* BON = (const float*)(p.ws + OFF_BON);
    const int c0 = 16 * lane, hh = lane >> 2;
    f32x4 lwv[4], lbv[4];
#pragma unroll
    for (int q = 0; q < 4; ++q) { lwv[q] = *(const f32x4*)(p.in[31] + c0 + 4 * q); lbv[q] = *(const f32x4*)(p.in[32] + c0 + 4 * q); }
    for (int mb = gw; mb < M; mb += 2 * NGW) {
        v4u ra[2][2], rb[2][2], rv[2][2], rg[2][2]; float bonv[2];
#pragma unroll
        for (int k = 0; k < 2; ++k) { const int m = (mb + k * NGW < M) ? mb + k * NGW : mb; const size_t ro = (size_t)m * D + c0;
#pragma unroll
            for (int q = 0; q < 2; ++q) { ra[k][q] = *(const v4u*)(Y0 + ro + 8 * q); rb[k][q] = *(const v4u*)(Y1 + ro + 8 * q); rv[k][q] = *(const v4u*)(Vb + ro + 8 * q); rg[k][q] = *(const v4u*)(Gb + ro + 8 * q); }
            bonv[k] = BON[(size_t)m * 16 + hh] + BON[(size_t)M * 16 + (size_t)m * 16 + hh]; }
#pragma unroll
        for (int k = 0; k < 2; ++k) { const int m = mb + k * NGW; if (m >= M) break;
            const size_t ro = (size_t)m * D + c0;
            float y[16], v[16], g[16];
#pragma unroll
            for (int q = 0; q < 2; ++q) {
                const unsigned aw[4] = {ra[k][q].x, ra[k][q].y, ra[k][q].z, ra[k][q].w}, bw[4] = {rb[k][q].x, rb[k][q].y, rb[k][q].z, rb[k][q].w};
                const unsigned vw[4] = {rv[k][q].x, rv[k][q].y, rv[k][q].z, rv[k][q].w}, gw_[4] = {rg[k][q].x, rg[k][q].y, rg[k][q].z, rg[k][q].w};
#pragma unroll
                for (int j = 0; j < 4; ++j) { y[8 * q + 2 * j] = bflo(aw[j]) + bflo(bw[j]); y[8 * q + 2 * j + 1] = bfhi(aw[j]) + bfhi(bw[j]);
                    v[8 * q + 2 * j] = bflo(vw[j]); v[8 * q + 2 * j + 1] = bfhi(vw[j]); g[8 * q + 2 * j] = bflo(gw_[j]); g[8 * q + 2 * j + 1] = bfhi(gw_[j]); }
            }
            float s_ = 0.f;
#pragma unroll
            for (int j = 0; j < 16; ++j) s_ += y[j];
            const float mean = red4(s_) * (1.f / 64.f);
            float q2 = 0.f;
#pragma unroll
            for (int j = 0; j < 16; ++j) { const float dd = y[j] - mean; q2 += dd * dd; }
            const float rstd = rsqrtf(red4(q2) * (1.f / 64.f) + 64e-5f);
            const float bon = bonv[k];
            unsigned o[8];
#pragma unroll
            for (int j = 0; j < 16; j += 2) {
                const float lw0 = lwv[j >> 2][j & 3], lw1 = lwv[j >> 2][(j & 3) + 1], lb0 = lbv[j >> 2][j & 3], lb1 = lbv[j >> 2][(j & 3) + 1];
                const float z0 = ((y[j] - mean) * rstd * lw0 + lb0 + bon * v[j]) * g[j];
                const float z1 = ((y[j + 1] - mean) * rstd * lw1 + lb1 + bon * v[j + 1]) * g[j + 1];
                o[j >> 1] = pk2(z0, z1);
            }
            *(v4u*)(Z + ro) = (v4u){o[0], o[1], o[2], o[3]};
            *(v4u*)(Z + ro + 8) = (v4u){o[4], o[5], o[6], o[7]};
        }
    }
}

template <bool GRID>
__device__ __forceinline__ void conv_item(const bf16* UPp, bf16* ACT, const float* wc, const float* bc, int f, int mline, bool up_ok, bool dn_ok, bool l_ok, bool r_ok) {
    constexpr int NR = GRID ? 3 : 1, R0 = GRID ? 0 : 1;
    f32x4 wv[NR][3], wg[NR][3];
#pragma unroll
    for (int r = 0; r < NR; ++r)
#pragma unroll
        for (int dx = 0; dx < 3; ++dx) { wv[r][dx] = *(const f32x4*)(wc + ((R0 + r) * 3 + dx) * F2 + f); wg[r][dx] = *(const f32x4*)(wc + ((R0 + r) * 3 + dx) * F2 + FH + f); }
    const f32x4 bv = *(const f32x4*)(bc + f), bg = *(const f32x4*)(bc + FH + f);
    v2u Pv[6][NR], Pg[6][NR];
#define CONV_LD(col_, mtok_, ok_) { _Pragma("unroll") for (int r = 0; r < NR; ++r) { \
        const bool rok_ = (ok_) && (!GRID || r == 1 || (r == 0 ? up_ok : dn_ok)); \
        if (rok_) { const bf16* pr_ = UPp + (size_t)((mtok_) + (GRID ? (r - 1) * 64 : 0)) * F2 + f; Pv[col_][r] = *(const v2u*)pr_; Pg[col_][r] = *(const v2u*)(pr_ + FH); } \
        else { Pv[col_][r] = (v2u){0u, 0u}; Pg[col_][r] = (v2u){0u, 0u}; } } }
    CONV_LD(0, mline - 1, l_ok)
    CONV_LD(1, mline, true)
#pragma unroll 1
    for (int x0 = 0; x0 < 64; x0 += 4) {
#pragma unroll
        for (int k = 0; k < 4; ++k) CONV_LD(2 + k, mline + x0 + 1 + k, (x0 + 1 + k < 64) || r_ok)
#pragma unroll
        for (int xx = 0; xx < 4; ++xx) {
            f32x4 av = bv, ag = bg;
#pragma unroll
            for (int r = 0; r < NR; ++r)
#pragma unroll
                for (int dx = 0; dx < 3; ++dx) { av += unpack4(Pv[xx + dx][r]) * wv[r][dx]; ag += unpack4(Pg[xx + dx][r]) * wg[r][dx]; }
            f32x4 o;
#pragma unroll
            for (int j = 0; j < 4; ++j) o[j] = ag[j] * __builtin_amdgcn_rcpf(1.0f + __expf(-ag[j])) * av[j];
            v2u ow; ow.x = pg8::cvt_pk_bf16(o[0], o[1]); ow.y = pg8::cvt_pk_bf16(o[2], o[3]);
            *(v2u*)(ACT + (size_t)(mline + x0 + xx) * FH + f) = ow;
        }
#pragma unroll
        for (int r = 0; r < NR; ++r) { Pv[0][r] = Pv[4][r]; Pg[0][r] = Pg[4][r]; Pv[1][r] = Pv[5][r]; Pg[1][r] = Pg[5][r]; }
    }
#undef CONV_LD
}
__device__ __forceinline__ void phase_conv(const Params& p, int layer) {
    const bf16* UPp = (const bf16*)(p.ws + OFF_A + A_UP); bf16* ACT = (bf16*)(p.ws + OFF_A + A_ACT);
    const float* wc = p.in[11] + (size_t)layer * 9 * F2; const float* bc = p.in[12] + (size_t)layer * F2;
    constexpr int NS = 4 * 32 * 704, NP = 16 * 4 * 704;
    const int lane = threadIdx.x & 63, wave = threadIdx.x >> 6, c = blockIdx.x;
    if (gridDim.x == 256) {
        if (c < 176) { const int b = c / 44, rem = c % 44, yg = rem / 11, qb = rem % 11, y = yg * 8 + wave, q = qb * 64 + lane;
            conv_item<true>(UPp, ACT, wc, bc, 4 * q, MP + b * 2048 + y * 64, y > 0, y < 31, false, false); }
        else { for (int iw = (c - 176) * 8 + wave; iw < NP / 64; iw += 80 * 8) { const int j = iw * 64 + lane, q = j % 704, r = j / 704, seg = r & 3, b = r >> 2;
            conv_item<false>(UPp, ACT, wc, bc, 4 * q, b * 256 + seg * 64, false, false, seg > 0, seg < 3); } }
        return;
    }
    for (int iw = blockIdx.x + gridDim.x * wave; iw < (NS + NP) / 64; iw += gridDim.x * 8) {
        const int it = iw * 64 + lane;
        if (it < NS) { const int q = it % 704, r = it / 704, y = r & 31, b = r >> 5;
            conv_item<true>(UPp, ACT, wc, bc, 4 * q, MP + b * 2048 + y * 64, y > 0, y < 31, false, false); }
        else { const int j = it - NS, q = j % 704, r = j / 704, seg = r & 3, b = r >> 2;
            conv_item<false>(UPp, ACT, wc, bc, 4 * q, b * 256 + seg * 64, false, false, seg > 0, seg < 3); }
    }
}

constexpr int TQ = 258;
constexpr int WSQ = 136;
__device__ __forceinline__ void phase_sgu_stats(const Params& p) {
    const int tid = threadIdx.x, lane = tid & 63, wave = tid >> 6;
    const int gw = blockIdx.x * 8 + wave, NGW = gridDim.x * 8;
    const bf16* V = (const bf16*)(p.ws + OFF_A + A_V);
    f32x2* STAT = (f32x2*)(p.ws + OFF_BON);
    for (int m = gw; m < M; m += 3 * NGW) {
        v4u a[3][4];
#pragma unroll
        for (int k = 0; k < 3; ++k) { const int mm = m + k * NGW;
#pragma unroll
            for (int j = 0; j < 4; ++j) a[k][j] = (mm < M) ? *(const v4u*)(V + (size_t)mm * E + (j * 64 + lane) * 8) : (v4u){0u, 0u, 0u, 0u}; }
#pragma unroll
        for (int k = 0; k < 3; ++k) { const int mm = m + k * NGW;
            float s = 0.f, s2 = 0.f;
#pragma unroll
            for (int j = 0; j < 4; ++j) { const unsigned aw[4] = {a[k][j].x, a[k][j].y, a[k][j].z, a[k][j].w};
#pragma unroll
                for (int e = 0; e < 4; ++e) { const float x0 = bflo(aw[e]), x1 = bfhi(aw[e]); s += x0 + x1; s2 += x0 * x0 + x1 * x1; } }
            s = wave_sum(s); s2 = wave_sum(s2);
            const float mean = s * (1.f / E), var = fmaxf(s2 * (1.f / E) - mean * mean, 0.f);
            if (lane == 0 && mm < M) STAT[mm] = (f32x2){mean, rsqrtf(var + 1e-5f)};
        }
    }
}
__device__ __forceinline__ void phase_sgu(const Params& p, unsigned char* lds) {
    const int tid = threadIdx.x, lane = tid & 63, wave = tid >> 6, fr = lane & 15, fq = lane >> 4;
    bf16* Tl = (bf16*)lds;
    bf16* WSl = (bf16*)(lds + 128 * TQ * 2);
    bf16* U = (bf16*)(p.ws + OFF_A + A_U); const bf16* V = (const bf16*)(p.ws + OFF_A + A_V);
    const bf16* WSb = (const bf16*)(p.ws + X_WS);
    const f32x2* STAT = (const f32x2*)(p.ws + OFF_BON);
    int gcur = -1;
    for (int it = blockIdx.x; it < 96 * 8; it += gridDim.x) {
        const int n = it >> 3, g = it & 7, m0 = n * 128;
        v4u tv[8];
#pragma unroll
        for (int i = 0; i < 8; ++i) { const int q = (tid >> 5) + 16 * i, c8 = (tid & 31) * 8; tv[i] = *(const v4u*)(V + (size_t)(m0 + q) * E + g * 256 + c8); }
        if (g != gcur) {
#pragma unroll
            for (int i = 0; i < 4; ++i) { const int idx = tid + 512 * i, pr = idx >> 4, qc = (idx & 15) * 8;
                *(v4u*)(WSl + pr * WSQ + qc) = *(const v4u*)(WSb + (size_t)g * 16384 + pr * 128 + qc); }
            gcur = g;
        }
        { const int c8 = (tid & 31) * 8;
          const f32x4 lw0 = *(const f32x4*)(p.in[34] + g * 256 + c8), lw1 = *(const f32x4*)(p.in[34] + g * 256 + c8 + 4);
          const f32x4 lb0 = *(const f32x4*)(p.in[35] + g * 256 + c8), lb1 = *(const f32x4*)(p.in[35] + g * 256 + c8 + 4);
#pragma unroll
          for (int i = 0; i < 8; ++i) {
            const int q = (tid >> 5) + 16 * i;
            const unsigned aw[4] = {tv[i].x, tv[i].y, tv[i].z, tv[i].w};
            const f32x2 st = STAT[m0 + q]; const float mean = st.x * (1.f / E), rstd = rsqrtf(fmaxf(st.y * (1.f / E) - mean * mean, 0.f) + 1e-5f);
            unsigned* dst = (unsigned*)(Tl + q * TQ + c8);
            dst[0] = pk2((bflo(aw[0]) - mean) * rstd * lw0.x + lb0.x, (bfhi(aw[0]) - mean) * rstd * lw0.y + lb0.y);
            dst[1] = pk2((bflo(aw[1]) - mean) * rstd * lw0.z + lb0.z, (bfhi(aw[1]) - mean) * rstd * lw0.w + lb0.w);
            dst[2] = pk2((bflo(aw[2]) - mean) * rstd * lw1.x + lb1.x, (bfhi(aw[2]) - mean) * rstd * lw1.y + lb1.y);
            dst[3] = pk2((bflo(aw[3]) - mean) * rstd * lw1.z + lb1.z, (bfhi(aw[3]) - mean) * rstd * lw1.w + lb1.w);
          } }
        v2u uv[8][2];
#pragma unroll
        for (int pt = 0; pt < 8; ++pt)
#pragma unroll
            for (int ct = 0; ct < 2; ++ct) uv[pt][ct] = *(const v2u*)(U + (size_t)(m0 + pt * 16 + fr) * E + g * 256 + (2 * wave + ct) * 16 + 4 * fq);
        __syncthreads();
        bf16x8 Xf[2][4];
#pragma unroll
        for (int ct = 0; ct < 2; ++ct)
#pragma unroll
            for (int kb = 0; kb < 4; ++kb) { const bf16* src = Tl + (kb * 32 + 8 * fq) * TQ + (2 * wave + ct) * 16 + fr; bf16x8 x;
#pragma unroll
                for (int e = 0; e < 8; ++e) x[e] = (short)src[e * TQ];
                Xf[ct][kb] = x; }
        const float* bs = p.in[37] + g * 128;
#pragma unroll
        for (int pt = 0; pt < 8; ++pt) {
            bf16x8 Yf[4];
#pragma unroll
            for (int kb = 0; kb < 4; ++kb) Yf[kb] = *(const bf16x8*)(WSl + (pt * 16 + fr) * WSQ + kb * 32 + 8 * fq);
            const int pp = pt * 16 + fr; const float bias = bs[pp];
#pragma unroll
            for (int ct = 0; ct < 2; ++ct) {
                f32x4 acc = (f32x4){0.f, 0.f, 0.f, 0.f};
#pragma unroll
                for (int kb = 0; kb < 4; ++kb) acc = __builtin_amdgcn_mfma_f32_16x16x32_bf16(Xf[ct][kb], Yf[kb], acc, 0, 0, 0);
                bf16* up = U + (size_t)(m0 + pp) * E + g * 256 + (2 * wave + ct) * 16 + 4 * fq;
                *(v2u*)up = pack4(unpack4(uv[pt][ct]) * (acc + bias));
            }
        }
        __syncthreads();
    }
}

__global__ void __launch_bounds__(512) mk_fwd(Params p) {
    extern __shared__ __attribute__((aligned(16))) unsigned char lds[];
    cg::grid_group grid = cg::this_grid();
    const int lo = p.ph_lo, hi = p.ph_hi, G = gridDim.x, c = blockIdx.x;
    PG8_LAS unsigned char* glds = (PG8_LAS unsigned char*)lds;
    unsigned char* WB = p.ws + OFF_W; unsigned char* AB = p.ws + OFF_A;
    const float* MOD = (const float*)(p.ws + OFF_MOD);
    volatile LAS unsigned* misc = (volatile LAS unsigned*)((LAS unsigned char*)lds + (LDS_BYTES - 64));
    if (threadIdx.x < 2) misc[threadIdx.x] = 0u;
    __syncthreads();
    XcdBarrier xbar; xbar.bar = (unsigned*)(p.ws + OFF_BAR); xbar.x = 0; xbar.st = misc;
    if (hi - lo > 1) xbar = xcd_barrier_post((unsigned*)(p.ws + OFF_BAR), misc);
    if (lo < 0) grid.sync();
#ifdef ONLY
#define EN(k) (((ONLY) >> (k)) & 1)
#else
#define EN(k) 1
#endif
#define IN(k) (EN(k) && lo <= (k) && (k) < hi)
#define REP(k) _Pragma("unroll 1") for (int rep_ = 0; rep_ < 1 + ((REPMASK >> (k)) & 1); ++rep_)
#define SEAM(k) do { if (lo <= (k) && (k) + 1 < hi) xcd_barrier(xbar); } while (0)
    if (IN(0)) REP(0) { phase_mod(p, lds); __syncthreads(); phase_w0(p, lds); }
    SEAM(0);
    if (IN(1)) REP(1) phase_mix(p);
    SEAM(1);
    if (IN(2)) {
        pg8::Gemm g{(const bf16*)AB, (const bf16*)(WB + W_L1), D, D, D, SL, (size_t)256 * 1024 * 2};
        pg8::Order S; S.init(M / 192, 1, 3, G, c);
        pg8::EpiL1 Ep{(bf16*)(AB + A_L1)};
        pg8::gemm_phase<pg8::EpiL1, 3>(glds, g, S, Ep);
    }
    SEAM(2);
    if (IN(3)) REP(3) {
        { pg8::Gemm g{(const bf16*)(AB + 3 * SL), (const bf16*)(WB + W_RKV), D, D, D, SL, (size_t)1024 * 1024 * 2};
          pg8::Order S; S.init(M / 192, 4, 3, G, c);
          pg8::EpiBf16<0, 3> Ep{(bf16*)AB, D, (size_t)M * D, 0, 0};
          pg8::gemm_phase<pg8::EpiBf16<0, 3>, 3>(glds, g, S, Ep); }
    }
    SEAM(3);
    if (IN(4)) REP(4) phase_scan(p, lds);
    SEAM(4);
    if (IN(5)) phase_post(p);
    SEAM(5);
    float* SSQ = (float*)(p.ws + OFF_SSQ);
    if (IN(6)) {
        pg8::Gemm g{(const bf16*)(AB + 5 * SL), (const bf16*)(WB + W_O), D, D, D, 0, 0};
        pg8::Order S; S.init(M / 192, 4, 1, G, c);
        pg8::EpiRes2 Ep{p.in[0], p.in[1], p.out, MOD + 2 * 1024, (bf16*)(AB + A_H), p.in[9], MOD + 4 * 1024, SSQ};
        pg8::gemm_phase<pg8::EpiRes2, 3>(glds, g, S, Ep);
    }
    SEAM(6);
    if (IN(8)) {
        pg8::Gemm g{(const bf16*)(AB + A_H), (const bf16*)(WB + W_UP), D, D, D, 0, 0};
        pg8::Order S; S.init(M / 256, F2 / 256, 1, G, c);
        pg8::EpiBf16R<0> Ep{(bf16*)(AB + A_UP), F2, 0, 0, SSQ, (const float*)(p.ws + BIAS0), F2, nullptr};
        pg8::gemm_phase(glds, g, S, Ep);
    }
    SEAM(8);
    if (IN(9)) { phase_conv(p, 0); { const int gt_ = blockIdx.x * 512 + threadIdx.x; for (int i = gt_; i < 2 * M / 4; i += gridDim.x * 512) *(f32x4*)((float*)(p.ws + OFF_BON) + 4 * i) = (f32x4){0.f, 0.f, 0.f, 0.f}; } }
    SEAM(9);
    if (IN(10)) {
        pg8::Gemm g{(const bf16*)(AB + A_ACT), (const bf16*)(WB + W_DN), FH, FH, FH, 0, 0};
        pg8::Order S; S.init(M / 192, 4, 1, G, c);
        pg8::EpiRes2 Ep{p.out, p.out + (size_t)MP * D, p.out, MOD + 5 * 1024, (bf16*)(AB + A_H2), p.in[8] + 1024, MOD + 5 * 6144 + 1024, SSQ + M};
        pg8::gemm_phase<pg8::EpiRes2, 3>(glds, g, S, Ep);
    }
    SEAM(10);
    if (IN(12)) {
        pg8::Gemm g{(const bf16*)(AB + A_H2), (const bf16*)(p.ws + X_SGIN), D, D, D, 0, 0};
        pg8::Order S; S.init(M / 256, 16, 1, G, c);
        pg8::EpiBf16R<1> Ep{(bf16*)(AB + A_U), E, E, (size_t)(A_V - A_U) / 2, SSQ + M, (const float*)(p.ws + BIAS1), 4096, (float*)(p.ws + OFF_BON)};
        pg8::gemm_phase(glds, g, S, Ep);
    }
    SEAM(12);
    if (IN(13)) phase_sgu(p, lds);
    SEAM(13);
    if (IN(14)) {
        pg8::Gemm g{(const bf16*)(AB + A_U), (const bf16*)(p.ws + X_SGOUT), E, E, E, 0, 0};
        pg8::Order S; S.init(M / 192, 4, 1, G, c);
        pg8::EpiRes2 Ep{p.out, p.out + (size_t)MP * D, p.out, MOD + 5 * 6144 + 2 * 1024, (bf16*)(AB + A_H), p.in[9] + 1024, MOD + 5 * 6144 + 4 * 1024, SSQ + 2 * M};
        pg8::gemm_phase<pg8::EpiRes2, 3>(glds, g, S, Ep);
    }
    SEAM(14);
    if (IN(16)) {
        pg8::Gemm g{(const bf16*)(AB + A_H), (const bf16*)(p.ws + X_UP1), D, D, D, 0, 0};
        pg8::Order S; S.init(M / 256, F2 / 256, 1, G, c);
        pg8::EpiBf16R<0> Ep{(bf16*)(AB + A_UP), F2, 0, 0, SSQ + 2 * M, (const float*)(p.ws + BIAS2), F2, nullptr};
        pg8::gemm_phase(glds, g, S, Ep);
    }
    SEAM(16);
    if (IN(17)) phase_conv(p, 1);
    SEAM(17);
    if (IN(18)) {
        pg8::Gemm g{(const bf16*)(AB + A_ACT), (const bf16*)(WB + W_RKV), FH, FH, FH, 0, 0};
        pg8::Order S; S.init(M / 192, 4, 1, G, c);
        if (G == 256) { pg8::EpiResFin Ep{p.out, p.out, MOD + 5 * 6144 + 5 * 1024, p.in[14], SSQ + 3 * M, (unsigned*)(SSQ + 4 * M)};
            pg8::gemm_phase<pg8::EpiResFin, 3>(glds, g, S, Ep); }
        else { pg8::EpiRes Ep{p.out, p.out + (size_t)MP * D, p.out, MOD + 5 * 6144 + 5 * 1024};
            pg8::gemm_phase<pg8::EpiRes, 3>(glds, g, S, Ep); }
    }
    if (G != 256) SEAM(18);
    for (int xs_ = 0; xs_ < XSYNC; ++xs_) xcd_barrier(xbar);
    if (G != 256 && IN(19)) phase_final(p);
#undef IN
#undef SEAM
}

extern "C" void kernel_launch(void* const* d_in, const int* in_sizes, int n_in, void* d_out, int out_size, void* d_ws, size_t ws_size, hipStream_t stream) {
    static int grid = 0;
    if (grid == 0) {
        if (n_in != 39 || ws_size < WS_NEED) { fprintf(stderr, "kernel_launch: expected 39 inputs and >= %zu bytes of workspace, got %d / %zu\n", (size_t)WS_NEED, n_in, ws_size); grid = -1; return; }
        int dev = 0, cus = 0, per_cu = 0;
        hipGetDevice(&dev);
        hipDeviceGetAttribute(&cus, hipDeviceAttributeMultiprocessorCount, dev);
        if (hipFuncSetAttribute((const void*)mk_fwd, hipFuncAttributeMaxDynamicSharedMemorySize, LDS_BYTES) != hipSuccess) { fprintf(stderr, "kernel_launch: hipFuncSetAttribute failed\n"); grid = -1; return; }
        if (hipOccupancyMaxActiveBlocksPerMultiprocessor(&per_cu, (const void*)mk_fwd, 512, LDS_BYTES) != hipSuccess || per_cu < 1) { fprintf(stderr, "kernel_launch: occupancy query failed (%d)\n", per_cu); per_cu = 1; }
        (void)hipGetLastError();
        grid = cus * per_cu;
        if (grid > 256) grid = 256;
    }
    if (grid < 0) return;
    Params p{};
    for (int i = 0; i < 39; ++i) p.in[i] = (const float*)d_in[i];
    p.out = (float*)d_out; p.ws = (unsigned char*)d_ws;
#if ONE_LAUNCH
    (void)hipMemsetAsync((char*)d_ws + OFF_BAR, 0, 16384, stream);
    p.ph_lo = 0; p.ph_hi = NPH;
    void* args[] = {&p};
    hipError_t e = hipLaunchCooperativeKernel((const void*)mk_fwd, dim3(grid), dim3(512), args, LDS_BYTES, stream);
    if (e != hipSuccess) fprintf(stderr, "cooperative launch failed: %s (grid %d)\n", hipGetErrorString(e), grid);
#else
    static const int order[NPH] = {0, 1, 2, 3, 4, 5, 6, 7, 8, 9, 10, 11, 12, 20, 13, 14, 15, 16, 17, 18, 19};
    for (int kk = 0; kk < NPH; ++kk) {
        const int k = order[kk];
        p.ph_lo = k; p.ph_hi = k + 1;
        hipLaunchKernelGGL(mk_fwd, dim3(grid), dim3(512), LDS_BYTES, stream, p);
    }
#endif
}
```

```cpp
#include <hip/hip_runtime.h>
#include <hip/hip_cooperative_groups.h>
#include <cstdio>
#include <cstdint>
namespace cg = cooperative_groups;

#ifndef ONE_LAUNCH
#define ONE_LAUNCH 1
#endif
#define REPMASK 0
#define XSYNC 0

typedef unsigned short bf16;
typedef unsigned v4u __attribute__((ext_vector_type(4)));
typedef unsigned v2u __attribute__((ext_vector_type(2)));
typedef float f32x4 __attribute__((ext_vector_type(4)));
typedef float f32x2 __attribute__((ext_vector_type(2)));
typedef short bf16x8 __attribute__((ext_vector_type(8)));
#define LAS __attribute__((address_space(3)))
#define LDS_WAIT() asm volatile("s_waitcnt lgkmcnt(0)" ::: "memory")

constexpr int D = 1024, MP = 4096, MS = 8192, M = MP + MS, FH = 2816, F2 = 5632, E = 2048;
constexpr size_t MiB = 1u << 20;
constexpr size_t OFF_MOD = 0;
constexpr size_t OFF_BAR = 512 * 1024;
constexpr size_t OFF_BON = 1 * MiB;
constexpr size_t OFF_BIAS = 2 * MiB + 512 * 1024;
constexpr size_t BIAS0 = OFF_BIAS, BIAS1 = BIAS0 + 5 * 5632 * 4, BIAS2 = BIAS1 + 5 * 4096 * 4;
constexpr size_t OFF_SSQ = OFF_BIAS + 300 * 1024;
constexpr size_t OFF_W = 3 * MiB;
constexpr size_t OFF_A = 34 * MiB;
constexpr size_t WS_NEED = 256 * MiB;
constexpr size_t OFF_W2 = 232 * MiB;
constexpr size_t X_SGIN = OFF_W2, X_SGOUT = OFF_W2 + 8 * MiB, X_UP1 = OFF_W2 + 12 * MiB, X_WS = OFF_W2 + 23 * MiB;
constexpr size_t W_RKV = 0, W_O = 6 * MiB, W_L1 = 8 * MiB, W_G2 = 9 * MiB + 512 * 1024, W_W2 = 10 * MiB, W_A2 = 10 * MiB + 256 * 1024, W_UP = 10 * MiB + 512 * 1024, W_DN = 21 * MiB + 512 * 1024;
constexpr size_t W1_SGIN = 0, W1_SGOUT = 8 * MiB, W1_UP = 12 * MiB, W1_DN = 23 * MiB, W1_WS = 28 * MiB + 512 * 1024;
constexpr size_t SL = 24 * MiB;
constexpr size_t A_L1 = 144 * MiB, A_G = 156 * MiB;
constexpr size_t A_H = 0, A_UP = 66 * MiB, A_ACT = 0;
constexpr size_t A_U = 24 * MiB, A_V = 72 * MiB, A_H2 = 120 * MiB;
constexpr int LDS_BYTES = 136 * 1024;
constexpr int NPH = 21;

struct Params {
    const float* in[39];
    float* out;
    unsigned char* ws;
    int ph_lo, ph_hi;
};

__device__ __forceinline__ unsigned f2bf(float f) { unsigned u = __builtin_bit_cast(unsigned, f); return (u + 0x7fffu + ((u >> 16) & 1u)) >> 16; }
__device__ __forceinline__ unsigned pk2(float lo, float hi) { unsigned r; asm("v_cvt_pk_bf16_f32 %0, %1, %2" : "=v"(r) : "v"(lo), "v"(hi)); return r; }
__device__ __forceinline__ float bflo(unsigned u) { return __builtin_bit_cast(float, u << 16); }
__device__ __forceinline__ float bfhi(unsigned u) { return __builtin_bit_cast(float, u & 0xffff0000u); }
__device__ __forceinline__ f32x4 unpack4(v2u a) { return (f32x4){bflo(a.x), bfhi(a.x), bflo(a.y), bfhi(a.y)}; }
__device__ __forceinline__ v2u pack4(f32x4 v) { v2u o; o.x = pk2(v.x, v.y); o.y = pk2(v.z, v.w); return o; }
__device__ __forceinline__ float wave_sum(float v) {
#pragma unroll
    for (int o = 1; o < 64; o <<= 1) v += __shfl_xor(v, o);
    return v;
}
template <int CTRL> __device__ __forceinline__ float dppf(float x) { return __builtin_bit_cast(float, __builtin_amdgcn_update_dpp(0, __builtin_bit_cast(int, x), CTRL, 0xF, 0xF, true)); }
__device__ __forceinline__ float red4(float x) { x += dppf<0xB1>(x); x += dppf<0x4E>(x); return x; }
__device__ __forceinline__ float red8(float x) { x = red4(x); x += dppf<0x141>(x); return x; }
__device__ __forceinline__ float red8s(float x) { x += dppf<0xB1>(x); asm("" : "+v"(x)); x += dppf<0x4E>(x); asm("" : "+v"(x)); x += dppf<0x141>(x); asm("" : "+v"(x)); return x; }
__device__ __forceinline__ float sigmoidf_(float x) { return 1.0f / (1.0f + __expf(-x)); }
__device__ __forceinline__ float tanhf_(float x) { return 1.0f - 2.0f / (1.0f + __expf(2.0f * x)); }


#define XB_TMO      128
#define XB_XCNT(j)  (256  + 64 * (j))
#define XB_XSUB(j)  (1280 + 64 * (j))
#define XB_XGEN(j)  (2304 + 64 * (j))
#define XB_TOP      3328
#define XB_TOPGEN   3392
#define XCD_BAR_WORDS 3456
#define XB_SPIN_CAP (1u << 22)
__device__ __forceinline__ unsigned xb_ld(unsigned* p)              { return __hip_atomic_load(p, __ATOMIC_RELAXED, __HIP_MEMORY_SCOPE_AGENT); }
__device__ __forceinline__ unsigned xb_add(unsigned* p, unsigned v) { return __hip_atomic_fetch_add(p, v, __ATOMIC_RELAXED, __HIP_MEMORY_SCOPE_AGENT); }
__device__ __forceinline__ unsigned xb_xcc_id() { return (unsigned)__builtin_amdgcn_s_getreg((3 << 11) | 20) & 0xFu; }
#define XB_SPIN(cond, bar) do { unsigned _sp = 0; while (cond) { __builtin_amdgcn_s_sleep(1); \
    if ((++_sp & 255u) == 0u) { if (xb_ld(&(bar)[XB_TMO])) break; if (_sp > XB_SPIN_CAP) { atomicAdd(&(bar)[XB_TMO], 1u); break; } } } } while (0)
struct XcdBarrier { unsigned* bar; unsigned x; volatile LAS unsigned* st; };
__device__ __forceinline__ XcdBarrier xcd_barrier_post(unsigned* bar, volatile LAS unsigned* st) {
    XcdBarrier b; b.bar = bar; b.x = xb_xcc_id(); b.st = st;
    if (threadIdx.x == 0) (void)xb_add(&bar[XB_XCNT(b.x)], 1u);
    return b;
}
__device__ __forceinline__ void xcd_barrier_complete(unsigned* bar, unsigned x, unsigned& nloc, unsigned& nx) {
    const unsigned G = gridDim.x * gridDim.y * gridDim.z;
    unsigned sum, cnt, mine, sp = 0u;
    for (;;) {
        sum = 0u; cnt = 0u; mine = 0u;
#pragma unroll
        for (unsigned j = 0; j < 16; ++j) { const unsigned c = xb_ld(&bar[XB_XCNT(j)]); sum += c; cnt += (c > 0u) ? 1u : 0u; mine = (j == x) ? c : mine; }
        if (sum == G) break;
        __builtin_amdgcn_s_sleep(1);
        if ((++sp & 255u) == 0u) { if (xb_ld(&bar[XB_TMO])) break; if (sp > XB_SPIN_CAP) { atomicAdd(&bar[XB_TMO], 1u); break; } }
    }
    nloc = mine > 0u ? mine : 1u; nx = cnt > 0u ? cnt : 1u;
}
__device__ __forceinline__ void xcd_barrier(const XcdBarrier& b) {
    asm volatile("s_waitcnt vmcnt(0)" ::: "memory");
    __syncthreads();
    if (threadIdx.x == 0) {
        unsigned* bar = b.bar;
        __builtin_amdgcn_s_waitcnt(0);
        unsigned nloc = b.st[0], nx = b.st[1];
        if (nloc == 0u) { xcd_barrier_complete(bar, b.x, nloc, nx); b.st[0] = nloc; b.st[1] = nx; }
        const unsigned old = xb_add(&bar[XB_XSUB(b.x)], 1u);
        const unsigned gen = old / nloc;
        if (old + 1u == (gen + 1u) * nloc) {
            __builtin_amdgcn_fence(__ATOMIC_RELEASE, "agent");
            asm volatile("s_waitcnt vmcnt(0)" ::: "memory");
            const unsigned og = xb_add(&bar[XB_TOP], 1u);
            const unsigned tg = og / nx;
            if (og + 1u == (tg + 1u) * nx) xb_add(&bar[XB_TOPGEN], 1u);
            else XB_SPIN(xb_ld(&bar[XB_TOPGEN]) == tg, bar);
            __builtin_amdgcn_fence(__ATOMIC_ACQUIRE, "agent");
            xb_add(&bar[XB_XGEN(b.x)], 1u);
            asm volatile("s_waitcnt vmcnt(0)" ::: "memory");
        } else {
            XB_SPIN(xb_ld(&bar[XB_XGEN(b.x)]) == gen, bar);
            __builtin_amdgcn_fence(__ATOMIC_ACQUIRE, "agent");
            asm volatile("s_waitcnt vmcnt(0)" ::: "memory");
        }
    }
    __syncthreads();
}

namespace pg8 {
#define PG8_LAS __attribute__((address_space(3)))
typedef unsigned short bf16_t;
typedef unsigned u32x4 __attribute__((ext_vector_type(4)));
constexpr int BM = 256, BK = 64, HALF = 128, HTB = HALF * BK * 2, STAGE_BYTES = 8 * HTB, NXCD = 8, WGM = 8;
__host__ __device__ __forceinline__ int lds_byte(int r, int c) { const int st = (r >> 4) * 2 + (c >> 5), rr = r & 15, cc = c & 31, ob = rr * 64 + cc * 2; return st * 1024 + (ob ^ (((ob >> 9) & 1) << 5)); }
__host__ __device__ __forceinline__ void stage_rc(int b, int& R, int& C) { const int st = b / 1024, sb = b % 1024, swz = sb ^ (((sb >> 9) & 1) << 5); R = (st >> 1) * 16 + swz / 64; C = (st & 1) * 32 + (swz % 64) / 2; }
__host__ __device__ __forceinline__ int perm32(int rho) { const int n = rho >> 4, i = rho & 15; return 8 * (i >> 2) + 4 * n + (i & 3); }

struct Unit { int pm, pn, z; };
struct Gemm { const bf16_t* A; const bf16_t* Bt; int lda, ldb, K; size_t zA, zB; };
struct Order {
    int nM, nN, per, nwg, G, c;
    __device__ void init(int nM_, int nN_, int nZ, int G_, int c_) { nM = nM_; nN = nN_; per = nM * nN; nwg = per * nZ; G = G_; c = c_; }
    __device__ bool next(int i, Unit& u) const {
        const long L = (long)i * G + c; if (L >= nwg) return false;
        u.z = (int)(L / per); int wgid = (int)(L % per);
        { const int q = per / NXCD, r = per % NXCD, xcd = wgid % NXCD, off = wgid / NXCD; wgid = (xcd < r ? xcd * (q + 1) : r * (q + 1) + (xcd - r) * q) + off; }
        const int nig = WGM * nN, gid = wgid / nig, fm = gid * WGM, gsz = (nM - fm) < WGM ? (nM - fm) : WGM;
        u.pm = fm + ((wgid % nig) % gsz); u.pn = (wgid % nig) / gsz; return true;
    }
};
__device__ __forceinline__ unsigned cvt_pk_bf16(float lo, float hi) { unsigned r; asm volatile("v_cvt_pk_bf16_f32 %0, %1, %2" : "=v"(r) : "v"(lo), "v"(hi)); return r; }
__device__ __forceinline__ f32x2 gelu_pk(f32x2 v) {
    const f32x2 av = __builtin_elementwise_abs(v), d = av * 0.2316418882f + 1.0f;
    f32x2 t; t.x = __builtin_amdgcn_rcpf(d.x); t.y = __builtin_amdgcn_rcpf(d.y);
    f32x2 q = t * 0.5307027145f + (-0.7265760135f); q = q * t + 0.7107068705f; q = q * t + (-0.142248368f); q = q * t + 0.127414796f; q = q * t;
    const f32x2 s = (v * v) * (-0.72134752044f);
    f32x2 e; e.x = __builtin_amdgcn_exp2f(s.x); e.y = __builtin_amdgcn_exp2f(s.y);
    const f32x2 m = v * (q * e), r = v - m;
    f32x2 o; o.x = v.x < 0.f ? m.x : r.x; o.y = v.y < 0.f ? m.y : r.y; return o;
}

template <int ACT, int MT = 4> struct EpiBf16 {
    static constexpr bool PERM = true;
    bf16_t* O; int ldc; size_t zstride; int split_cols; size_t split_stride;
    __device__ __forceinline__ void operator()(const f32x4 (&acc)[2][2][MT][2], const Unit& u, int wr, int wc, int fr, int fq) const {
        const int row0 = u.pm * (64 * MT) + wr * (16 * MT) + fr; int colt = u.pn * BM; bf16_t* base = O + (size_t)u.z * zstride;
        if (split_cols) { const int t = colt / split_cols; base += (size_t)t * split_stride; colt -= t * split_cols; }
        const int col0 = colt + wc * 32 + 8 * fq;
#pragma unroll
        for (int ai = 0; ai < 2; ++ai)
#pragma unroll
            for (int m = 0; m < MT; ++m) { bf16_t* rowp = base + (size_t)(row0 + ai * (32 * MT) + m * 16) * ldc + col0;
#pragma unroll
                for (int bj = 0; bj < 2; ++bj) { f32x4 v0 = acc[ai][bj][m][0], v1 = acc[ai][bj][m][1];
                    if (ACT == 1) { f32x2 a = gelu_pk((f32x2){v0[0], v0[1]}), b = gelu_pk((f32x2){v0[2], v0[3]}), c = gelu_pk((f32x2){v1[0], v1[1]}), d = gelu_pk((f32x2){v1[2], v1[3]});
                        v0 = (f32x4){a.x, a.y, b.x, b.y}; v1 = (f32x4){c.x, c.y, d.x, d.y}; }
                    u32x4 w; w.x = cvt_pk_bf16(v0[0], v0[1]); w.y = cvt_pk_bf16(v0[2], v0[3]); w.z = cvt_pk_bf16(v1[0], v1[1]); w.w = cvt_pk_bf16(v1[2], v1[3]);
                    *(u32x4*)(rowp + bj * HALF) = w; } }
    }
};
struct EpiL1 {
    static constexpr bool PERM = true;
    bf16_t* L1;
    __device__ __forceinline__ void operator()(const f32x4 (&acc)[2][2][4][2], const Unit& u, int wr, int wc, int fr, int fq) const {
        const int row0 = u.pm * BM + wr * 64 + fr, col0 = wc * 32 + 8 * fq, z = u.z;
#pragma unroll
        for (int ai = 0; ai < 2; ++ai)
#pragma unroll
            for (int m = 0; m < 4; ++m) { bf16_t* rowp = L1 + (size_t)(row0 + ai * HALF + m * 16) * 512 + z * 128 + col0;
                f32x4 v0 = acc[ai][0][m][0], v1 = acc[ai][0][m][1];
#pragma unroll
                for (int j = 0; j < 4; ++j) {
                    if (z == 0) { v0[j] = tanhf_(v0[j]); v1[j] = tanhf_(v1[j]); }
                    else if (z == 2) { v0[j] = sigmoidf_(v0[j]); v1[j] = sigmoidf_(v1[j]); } }
                u32x4 w; w.x = cvt_pk_bf16(v0[0], v0[1]); w.y = cvt_pk_bf16(v0[2], v0[3]); w.z = cvt_pk_bf16(v1[0], v1[1]); w.w = cvt_pk_bf16(v1[2], v1[3]);
                *(u32x4*)rowp = w;
                if (z == 2) *(u32x4*)(rowp + 128) = (u32x4){0u, 0u, 0u, 0u}; }
    }
};
__device__ __forceinline__ int cond_row(int m) { return m < MP ? 0 : 1 + ((m - MP) >> 11); }
struct EpiRes {
    static constexpr bool PERM = false;
    const float* xp; const float* xs; float* out; const float* gate;
    __device__ __forceinline__ void operator()(const f32x4 (&acc)[2][2][3][2], const Unit& u, int wr, int wc, int fr, int fq) const {
        const int row0 = u.pm * 192 + wr * 48 + fr, col0 = u.pn * BM + wc * 32 + 4 * fq;
#pragma unroll
        for (int ai = 0; ai < 2; ++ai)
#pragma unroll
            for (int m = 0; m < 3; ++m) { const int row = row0 + ai * 96 + m * 16; const int ci = cond_row(row);
                const float* xin = (row < MP ? xp : xs - (size_t)MP * D) + (size_t)row * D + col0; float* op = out + (size_t)row * D + col0;
#pragma unroll
                for (int bj = 0; bj < 2; ++bj)
#pragma unroll
                    for (int n = 0; n < 2; ++n) { const int co = bj * HALF + n * 16;
                        const f32x4 gv = *(const f32x4*)(gate + ci * 6144 + col0 + co);
                        *(f32x4*)(op + co) = *(const f32x4*)(xin + co) + gv * acc[ai][bj][m][n]; } }
    }
};
struct EpiRes2 {
    static constexpr bool PERM = false;
    const float* xp; const float* xs; float* out; const float* gate; bf16_t* Hn; const float* gn; const float* scn; float* ssq;
    __device__ __forceinline__ void operator()(const f32x4 (&acc)[2][2][3][2], const Unit& u, int wr, int wc, int fr, int fq) const {
        const int row0 = u.pm * 192 + wr * 48 + fr, col0 = u.pn * BM + wc * 32 + 4 * fq;
        const int ciA = cond_row(u.pm * 192), ciB = cond_row(u.pm * 192 + 191);
        f32x4 g4[2][2];
#pragma unroll
        for (int bj = 0; bj < 2; ++bj)
#pragma unroll
            for (int n = 0; n < 2; ++n) g4[bj][n] = *(const f32x4*)(gn + col0 + bj * HALF + n * 16);
        if (ciA == ciB) {
            f32x4 gv4[2][2];
#pragma unroll
            for (int bj = 0; bj < 2; ++bj)
#pragma unroll
                for (int n = 0; n < 2; ++n) { const int co = bj * HALF + n * 16;
                    gv4[bj][n] = *(const f32x4*)(gate + ciA * 6144 + col0 + co);
                    g4[bj][n] = g4[bj][n] * (*(const f32x4*)(scn + ciA * 6144 + col0 + co) + 1.0f); }
            const float* xin0 = (u.pm * 192 < MP ? xp : xs - (size_t)MP * D);
#pragma unroll
            for (int ai = 0; ai < 2; ++ai)
#pragma unroll
                for (int m = 0; m < 3; ++m) { const int row = row0 + ai * 96 + m * 16;
                    const float* xin = xin0 + (size_t)row * D + col0; float* op = out + (size_t)row * D + col0; bf16_t* hp = Hn + (size_t)row * D + col0;
                    float rs = 0.f;
#pragma unroll
                    for (int bj = 0; bj < 2; ++bj)
#pragma unroll
                        for (int n = 0; n < 2; ++n) { const int co = bj * HALF + n * 16;
                            const f32x4 o = *(const f32x4*)(xin + co) + gv4[bj][n] * acc[ai][bj][m][n];
                            *(f32x4*)(op + co) = o;
                            rs += (o.x * o.x + o.y * o.y) + (o.z * o.z + o.w * o.w);
                            const f32x4 a = o * g4[bj][n]; const unsigned w0 = cvt_pk_bf16(a.x, a.y), w1 = cvt_pk_bf16(a.z, a.w);
                            *(v2u*)(hp + co) = (v2u){w0, w1}; }
                    rs += __shfl_xor(rs, 16); rs += __shfl_xor(rs, 32);
                    if (fq == 0) atomicAdd(ssq + row, rs); }
            return;
        }
#pragma unroll
        for (int ai = 0; ai < 2; ++ai)
#pragma unroll
            for (int m = 0; m < 3; ++m) { const int row = row0 + ai * 96 + m * 16; const int ci = cond_row(row);
                const float* xin = (row < MP ? xp : xs - (size_t)MP * D) + (size_t)row * D + col0; float* op = out + (size_t)row * D + col0; bf16_t* hp = Hn + (size_t)row * D + col0;
                float rs = 0.f;
#pragma unroll
                for (int bj = 0; bj < 2; ++bj)
#pragma unroll
                    for (int n = 0; n < 2; ++n) { const int co = bj * HALF + n * 16;
                        const f32x4 gv = *(const f32x4*)(gate + ci * 6144 + col0 + co);
                        const f32x4 gsn = g4[bj][n] * (*(const f32x4*)(scn + ci * 6144 + col0 + co) + 1.0f);
                        const f32x4 o = *(const f32x4*)(xin + co) + gv * acc[ai][bj][m][n];
                        *(f32x4*)(op + co) = o;
                        rs += (o.x * o.x + o.y * o.y) + (o.z * o.z + o.w * o.w);
                        const f32x4 a = o * gsn; const unsigned w0 = cvt_pk_bf16(a.x, a.y), w1 = cvt_pk_bf16(a.z, a.w);
                        *(v2u*)(hp + co) = (v2u){w0, w1}; }
                rs += __shfl_xor(rs, 16); rs += __shfl_xor(rs, 32);
                if (fq == 0) atomicAdd(ssq + row, rs); }
    }
};
struct EpiResFin {
    static constexpr bool PERM = false;
    const float* xin_; float* out; const float* gate; const float* gfin; float* ssq; unsigned* cnt;
    __device__ __forceinline__ void operator()(f32x4 (&acc)[2][2][3][2], const Unit& u, int wr, int wc, int fr, int fq) const {
        const int row0 = u.pm * 192 + wr * 48 + fr, col0 = u.pn * BM + wc * 32 + 4 * fq;
#pragma unroll
        for (int ai = 0; ai < 2; ++ai)
#pragma unroll
            for (int m = 0; m < 3; ++m) { const int row = row0 + ai * 96 + m * 16; const int ci = cond_row(row);
                const float* xin = xin_ + (size_t)row * D + col0; float rs = 0.f;
#pragma unroll
                for (int bj = 0; bj < 2; ++bj)
#pragma unroll
                    for (int n = 0; n < 2; ++n) { const int co = bj * HALF + n * 16;
                        const f32x4 gv = *(const f32x4*)(gate + ci * 6144 + col0 + co);
                        const f32x4 o = *(const f32x4*)(xin + co) + gv * acc[ai][bj][m][n];
                        acc[ai][bj][m][n] = o;
                        rs += (o.x * o.x + o.y * o.y) + (o.z * o.z + o.w * o.w); }
                rs += __shfl_xor(rs, 16); rs += __shfl_xor(rs, 32);
                if (fq == 0) atomicAdd(ssq + row, rs); }
        asm volatile("s_waitcnt vmcnt(0)" ::: "memory");
        unsigned* cw = cnt + 64 * u.pm;
        if (fr == 0 && fq == 0) __hip_atomic_fetch_add(cw, 1u, __ATOMIC_RELAXED, __HIP_MEMORY_SCOPE_AGENT);
        { unsigned sp = 0;
          while ((unsigned)__builtin_amdgcn_readfirstlane((int)__hip_atomic_load(cw, __ATOMIC_RELAXED, __HIP_MEMORY_SCOPE_AGENT)) < 32u) { __builtin_amdgcn_s_sleep(2); if (++sp > (1u << 22)) break; } }
#pragma unroll
        for (int ai = 0; ai < 2; ++ai)
#pragma unroll
            for (int m = 0; m < 3; ++m) { const int row = row0 + ai * 96 + m * 16;
                const float rstd = rsqrtf(__hip_atomic_load(ssq + row, __ATOMIC_RELAXED, __HIP_MEMORY_SCOPE_AGENT) * (1.0f / D) + 1e-6f);
                float* op = out + (size_t)row * D + col0;
#pragma unroll
                for (int bj = 0; bj < 2; ++bj)
#pragma unroll
                    for (int n = 0; n < 2; ++n) { const int co = bj * HALF + n * 16;
                        *(f32x4*)(op + co) = acc[ai][bj][m][n] * rstd * *(const f32x4*)(gfin + col0 + co); } }
    }
};
template <int ACT> struct EpiBf16R {
    static constexpr bool PERM = true;
    bf16_t* O; int ldc; int split_cols; size_t split_stride; const float* ssq; const float* bias; int nb; float* stat2;
    __device__ __forceinline__ void operator()(const f32x4 (&acc)[2][2][4][2], const Unit& u, int wr, int wc, int fr, int fq) const {
        const int row0 = u.pm * BM + wr * 64 + fr; int colt = u.pn * BM; bf16_t* base = O;
        const bool dostat = stat2 != nullptr && split_cols && colt >= split_cols;
        float st1[2][4], st2[2][4];
#pragma unroll
        for (int ai = 0; ai < 2; ++ai)
#pragma unroll
            for (int m = 0; m < 4; ++m) { st1[ai][m] = 0.f; st2[ai][m] = 0.f; }
        const int ci = u.pm < 16 ? 0 : 1 + ((u.pm - 16) >> 3);
        const int bcol0 = colt + wc * 32 + 8 * fq;
        if (split_cols) { const int t = colt / split_cols; base += (size_t)t * split_stride; colt -= t * split_cols; }
        const int col0 = colt + wc * 32 + 8 * fq;
        float rstd[2][4];
#pragma unroll
        for (int ai = 0; ai < 2; ++ai)
#pragma unroll
            for (int m = 0; m < 4; ++m) rstd[ai][m] = rsqrtf(ssq[row0 + ai * HALF + m * 16] * (1.0f / D) + 1e-6f);
#pragma unroll
        for (int bj = 0; bj < 2; ++bj) {
            const f32x4 b0 = *(const f32x4*)(bias + (size_t)ci * nb + bcol0 + bj * HALF), b1 = *(const f32x4*)(bias + (size_t)ci * nb + bcol0 + bj * HALF + 4);
#pragma unroll
            for (int ai = 0; ai < 2; ++ai)
#pragma unroll
                for (int m = 0; m < 4; ++m) { bf16_t* rowp = base + (size_t)(row0 + ai * HALF + m * 16) * ldc + col0;
                    f32x4 v0 = acc[ai][bj][m][0] * rstd[ai][m] + b0, v1 = acc[ai][bj][m][1] * rstd[ai][m] + b1;
                    if (ACT == 1) { f32x2 a = gelu_pk((f32x2){v0[0], v0[1]}), b = gelu_pk((f32x2){v0[2], v0[3]}), c = gelu_pk((f32x2){v1[0], v1[1]}), d = gelu_pk((f32x2){v1[2], v1[3]});
                        v0 = (f32x4){a.x, a.y, b.x, b.y}; v1 = (f32x4){c.x, c.y, d.x, d.y}; }
                    u32x4 w; w.x = cvt_pk_bf16(v0[0], v0[1]); w.y = cvt_pk_bf16(v0[2], v0[3]); w.z = cvt_pk_bf16(v1[0], v1[1]); w.w = cvt_pk_bf16(v1[2], v1[3]);
                    *(u32x4*)(rowp + bj * HALF) = w;
                    if (ACT == 1 && dostat) { st1[ai][m] += ((v0[0] + v0[1]) + (v0[2] + v0[3])) + ((v1[0] + v1[1]) + (v1[2] + v1[3]));
                        st2[ai][m] += ((v0[0] * v0[0] + v0[1] * v0[1]) + (v0[2] * v0[2] + v0[3] * v0[3])) + ((v1[0] * v1[0] + v1[1] * v1[1]) + (v1[2] * v1[2] + v1[3] * v1[3])); } }
        }
        if (ACT == 1 && dostat) {
#pragma unroll
            for (int ai = 0; ai < 2; ++ai)
#pragma unroll
                for (int m = 0; m < 4; ++m) { float a = st1[ai][m], b = st2[ai][m];
                    a += __shfl_xor(a, 16); a += __shfl_xor(a, 32); b += __shfl_xor(b, 16); b += __shfl_xor(b, 32);
                    if (fq == 0) { float* sp = stat2 + 2 * (size_t)(row0 + ai * HALF + m * 16); atomicAdd(sp, a); atomicAdd(sp + 1, b); } }
        }
    }
};

template <class Epi, int MT = 4>
__device__ __forceinline__ void gemm_phase(PG8_LAS unsigned char* lds, const Gemm g, const Order& S, const Epi& E) {
    const int tid = threadIdx.x, wid = __builtin_amdgcn_readfirstlane(tid >> 6), lane = tid & 63, wr = wid >> 2, wc = wid & 3, fr = lane & 15, fq = lane >> 4;
    const int K = g.K, nt = K / BK;
    unsigned voffA[2], voffB[2];
#pragma unroll
    for (int i = 0; i < 2; ++i) { int R, C; stage_rc(tid * 16 + i * 8192, R, C); const int Rb = Epi::PERM ? ((R & ~31) + perm32(R & 31)) : R;
        voffA[i] = (unsigned)(R * g.lda + C) * 2u; voffB[i] = (unsigned)(Rb * g.ldb + C) * 2u; }
    const size_t kstep = (size_t)(BK * 2);
    const size_t hA = (size_t)(32 * MT) * g.lda * 2, hB = (size_t)HALF * g.ldb * 2, tA = 2 * hA, tB = 2 * hB;
    const unsigned ldsw = (unsigned)wid * 1024u;
    const int aoff = lds_byte(wr * 16 * MT + fr, fq * 8), boff = lds_byte(wc * 32 + fr, fq * 8);
#define PG8_SA(b, h) (((b) * 2 + (h)) * HTB)
#define PG8_SB(b, h) ((4 + (b) * 2 + (h)) * HTB)
#define PG8_STAGE(bufoff, gbase, voff) do { _Pragma("unroll") for (int _i = 0; _i < 2; ++_i) \
        __builtin_amdgcn_global_load_lds((const unsigned*)((const char*)(gbase) + (voff)[_i]), (PG8_LAS unsigned*)(lds + (bufoff) + ldsw + _i * 8192), 16, 0, 0); } while (0)
#define PG8_LDA(dst, b, h) do { _Pragma("unroll") for (int m = 0; m < MT; ++m) _Pragma("unroll") for (int k = 0; k < 2; ++k) dst[m][k] = *(const PG8_LAS bf16x8*)(lds + PG8_SA(b, h) + aoff + m * 2048 + k * 1024); } while (0)
#define PG8_LDB(dst, b, h) do { _Pragma("unroll") for (int n = 0; n < 2; ++n) _Pragma("unroll") for (int k = 0; k < 2; ++k) dst[n][k] = *(const PG8_LAS bf16x8*)(lds + PG8_SB(b, h) + boff + n * 2048 + k * 1024); } while (0)
#define PG8_MMA(ai, bj, At, Bt) do { __builtin_amdgcn_s_setprio(1); _Pragma("unroll") for (int m = 0; m < MT; ++m) _Pragma("unroll") for (int n = 0; n < 2; ++n) _Pragma("unroll") for (int k = 0; k < 2; ++k) \
        acc[ai][bj][m][n] = __builtin_amdgcn_mfma_f32_16x16x32_bf16(Bt[n][k], At[m][k], acc[ai][bj][m][n], 0, 0, 0); __builtin_amdgcn_s_setprio(0); } while (0)
#define PG8_WAIT_V(n) asm volatile("s_waitcnt vmcnt(" #n ")" ::: "memory")
#define PG8_WAIT_L(n) asm volatile("s_waitcnt lgkmcnt(" #n ")" ::: "memory")
#define PG8_BAR __builtin_amdgcn_s_barrier()
#define PG8_SCHED __builtin_amdgcn_sched_barrier(0)
    Unit cur, nxt; int ui = 0;
    if (!S.next(0, cur)) return;
    f32x4 acc[2][2][MT][2];
#pragma unroll
    for (int a = 0; a < 2; ++a)
#pragma unroll
        for (int b = 0; b < 2; ++b)
#pragma unroll
            for (int m = 0; m < MT; ++m)
#pragma unroll
                for (int n = 0; n < 2; ++n) acc[a][b][m][n] = (f32x4){0.f, 0.f, 0.f, 0.f};
    bf16x8 At[MT][2], B0[2][2], B1[2][2];
    const char* cA = (const char*)g.A + (size_t)cur.z * g.zA + (size_t)cur.pm * tA; const char* cB = (const char*)g.Bt + (size_t)cur.z * g.zB + (size_t)cur.pn * tB;
    PG8_STAGE(PG8_SB(0, 0), cB, voffB); PG8_STAGE(PG8_SB(0, 1), cB + hB, voffB); PG8_STAGE(PG8_SA(0, 0), cA, voffA); PG8_STAGE(PG8_SA(0, 1), cA + hA, voffA);
    if (wr == 1) PG8_BAR;
    PG8_WAIT_V(2); PG8_BAR;
    PG8_STAGE(PG8_SB(1, 0), cB + kstep, voffB); PG8_STAGE(PG8_SA(1, 0), cA + kstep, voffA); PG8_STAGE(PG8_SB(1, 1), cB + hB + kstep, voffB);
    PG8_WAIT_V(6); PG8_BAR;
    for (;;) {
        const bool has_next = S.next(ui + 1, nxt);
        const char* nA = has_next ? (const char*)g.A + (size_t)nxt.z * g.zA + (size_t)nxt.pm * tA : cA; const char* nB = has_next ? (const char*)g.Bt + (size_t)nxt.z * g.zB + (size_t)nxt.pn * tB : cB;
        for (int t = 0; t < nt; t += 2) {
            const bool last = (t == nt - 2);
            const char* a1 = cA + (size_t)(t + 1) * kstep;
            const char* a2 = last ? nA : cA + (size_t)(t + 2) * kstep; const char* b2 = last ? nB : cB + (size_t)(t + 2) * kstep;
            const char* a3 = a2 + kstep; const char* b3 = b2 + kstep;
            PG8_LDB(B0, 0, 0); PG8_LDB(B1, 0, 1); PG8_SCHED; PG8_LDA(At, 0, 0); PG8_STAGE(PG8_SA(1, 1), a1 + hA, voffA);
            PG8_WAIT_V(8); PG8_WAIT_L(0); PG8_BAR; PG8_MMA(0, 0, At, B0); PG8_MMA(0, 1, At, B1); PG8_BAR; PG8_SCHED;
            PG8_LDA(At, 0, 1); PG8_STAGE(PG8_SB(0, 0), b2, voffB); PG8_STAGE(PG8_SB(0, 1), b2 + hB, voffB); PG8_STAGE(PG8_SA(0, 0), a2, voffA);
            PG8_WAIT_V(8); PG8_WAIT_L(0); PG8_BAR; PG8_MMA(1, 0, At, B0); PG8_MMA(1, 1, At, B1); PG8_BAR; PG8_SCHED;
            PG8_LDB(B0, 1, 0); PG8_LDB(B1, 1, 1); PG8_SCHED; PG8_LDA(At, 1, 0); PG8_STAGE(PG8_SA(0, 1), a2 + hA, voffA);
            PG8_WAIT_V(8); PG8_WAIT_L(0); PG8_BAR; PG8_MMA(0, 0, At, B0); PG8_MMA(0, 1, At, B1); PG8_BAR; PG8_SCHED;
            PG8_LDA(At, 1, 1); PG8_STAGE(PG8_SB(1, 0), b3, voffB); PG8_STAGE(PG8_SB(1, 1), b3 + hB, voffB); PG8_STAGE(PG8_SA(1, 0), a3, voffA);
            PG8_WAIT_V(8); PG8_WAIT_L(0); PG8_BAR; PG8_MMA(1, 0, At, B0); PG8_MMA(1, 1, At, B1); PG8_BAR; PG8_SCHED;
        }
        if (wr == 0) PG8_BAR;
        E(acc, cur, wr, wc, fr, fq);
        if (!has_next) break;
#pragma unroll
        for (int a = 0; a < 2; ++a)
#pragma unroll
            for (int b = 0; b < 2; ++b)
#pragma unroll
                for (int m = 0; m < MT; ++m)
#pragma unroll
                    for (int n = 0; n < 2; ++n) acc[a][b][m][n] = (f32x4){0.f, 0.f, 0.f, 0.f};
        cur = nxt; cA = nA; cB = nB; ++ui;
        if (wr == 1) PG8_BAR;
    }
    PG8_WAIT_V(0);
    PG8_BAR;
#undef PG8_SA
#undef PG8_SB
#undef PG8_STAGE
#undef PG8_LDA
#undef PG8_LDB
#undef PG8_MMA
#undef PG8_WAIT_V
#undef PG8_WAIT_L
#undef PG8_BAR
#undef PG8_SCHED
}
}

__device__ __forceinline__ int cond_of(int m) { return m < MP ? 0 : 1 + ((m - MP) >> 11); }

__device__ __forceinline__ void transpose_item(const float* W, int K, int N, bf16* WT, int ldk, int row_off, LAS float* scr, int item, int lane) {
    const int nblk = N / 64, kb = item / nblk, nb = item % nblk, k0 = 64 * kb, n0 = 64 * nb;
    const float* src = W + (size_t)k0 * N + n0 + lane;
#pragma unroll 16
    for (int i = 0; i < 64; ++i) scr[i * 65 + lane] = src[(size_t)i * N];
    LDS_WAIT();
    const int c = lane & 7;
#pragma unroll
    for (int j = 0; j < 8; ++j) { const int n = (lane >> 3) + 8 * j; const LAS float* t = scr + (8 * c) * 65 + n;
        v4u o; o.x = pk2(t[0 * 65], t[1 * 65]); o.y = pk2(t[2 * 65], t[3 * 65]); o.z = pk2(t[4 * 65], t[5 * 65]); o.w = pk2(t[6 * 65], t[7 * 65]);
        *(v4u*)(WT + (size_t)(row_off + n0 + n) * ldk + k0 + 8 * c) = o; }
    LDS_WAIT();
}
#define TR_JOB(W_, K_, N_, WT_, LD_, RO_) { const int ni = ((K_) / 64) * ((N_) / 64); if (r < ni) { transpose_item((W_), (K_), (N_), (WT_), (LD_), (RO_), scr, r, lane); continue; } r -= ni; }

__device__ __forceinline__ void phase_mod(const Params& p, unsigned char* lds) {
    float* sc = (float*)lds;
    float* red = sc + 5 * 1024;
    const int tid = threadIdx.x;
    if ((int)blockIdx.x < 192) {
        for (int i = tid; i < 5 * 1024; i += 512) { const int ci = i >> 10, k = i & 1023; const float x = ci == 0 ? p.in[5][k] : p.in[4][(ci - 1) * 1024 + k]; sc[i] = x / (1.0f + __expf(-x)); }
    }
    __syncthreads();
    float* MOD = (float*)(p.ws + OFF_MOD);
    for (int it = blockIdx.x; it < 192; it += gridDim.x) {
        const int layer = it / 96, n0 = (it % 96) * 64, ks = tid >> 6, nl = tid & 63;
        const float* W = p.in[6] + (size_t)layer * 1024 * 6144 + n0 + nl;
        float a0 = 0.f, a1 = 0.f, a2 = 0.f, a3 = 0.f, a4 = 0.f;
#pragma unroll 8
        for (int k = ks * 128; k < ks * 128 + 128; ++k) { const float w = W[(size_t)k * 6144];
            a0 += sc[k] * w; a1 += sc[1024 + k] * w; a2 += sc[2048 + k] * w; a3 += sc[3072 + k] * w; a4 += sc[4096 + k] * w; }
        red[(ks * 5 + 0) * 64 + nl] = a0; red[(ks * 5 + 1) * 64 + nl] = a1; red[(ks * 5 + 2) * 64 + nl] = a2; red[(ks * 5 + 3) * 64 + nl] = a3; red[(ks * 5 + 4) * 64 + nl] = a4;
        __syncthreads();
        if (tid < 320) { const int ci = tid >> 6; float s = p.in[7][layer * 6144 + n0 + nl];
#pragma unroll
            for (int q = 0; q < 8; ++q) s += red[(q * 5 + ci) * 64 + nl];
            MOD[(layer * 5 + ci) * 6144 + n0 + nl] = s; }
        __syncthreads();
    }
}
__device__ __forceinline__ void phase_w0(const Params& p, unsigned char* lds) {
    const int tid = threadIdx.x, lane = tid & 63, wave = tid >> 6;
    LAS float* scr = (LAS float*)((LAS unsigned char*)lds) + wave * (64 * 65);
    const int gw = blockIdx.x * 8 + wave, NGW = gridDim.x * 8;
    unsigned char* WB = p.ws + OFF_W;
    bf16* wrkv = (bf16*)(WB + W_RKV); bf16* wo = (bf16*)(WB + W_O); bf16* wl1 = (bf16*)(WB + W_L1); bf16* g2t = (bf16*)(WB + W_G2);
    bf16* w2t = (bf16*)(WB + W_W2); bf16* a2t = (bf16*)(WB + W_A2); bf16* upt = (bf16*)(WB + W_UP); bf16* dnt = (bf16*)(WB + W_DN);
    constexpr int NITEMS = 3 * 256 + 4 * 16 + 32 + 32 + 4 * 16;
    for (int it = gw; it < NITEMS; it += NGW) {
        int r = it;
        TR_JOB(p.in[16], 1024, 1024, wrkv, 1024, 0)
        TR_JOB(p.in[17], 1024, 1024, wrkv, 1024, 1024)
        TR_JOB(p.in[18], 1024, 1024, wrkv, 1024, 2048)
        TR_JOB(p.in[21], 1024, 64, wl1, 1024, 0)
        TR_JOB(p.in[21] + 1024 * 64, 1024, 64, wl1, 1024, 64)
        TR_JOB(p.in[24], 1024, 64, wl1 + 256 * 1024, 1024, 0)
        TR_JOB(p.in[24] + 1024 * 64, 1024, 64, wl1 + 256 * 1024, 1024, 64)
        TR_JOB(p.in[26], 1024, 128, wl1 + 512 * 1024, 1024, 0)
        TR_JOB(p.in[27], 128, 1024, g2t, 256, 0)
        TR_JOB(p.in[22], 64, 1024, w2t, 64, 0)
        TR_JOB(p.in[22] + 64 * 1024, 64, 1024, w2t + 1024 * 64, 64, 0)
        TR_JOB(p.in[25], 64, 1024, a2t, 64, 0)
        TR_JOB(p.in[25] + 64 * 1024, 64, 1024, a2t + 1024 * 64, 64, 0)
    }
    const int gt = blockIdx.x * 512 + tid, GT = gridDim.x * 512;
    for (int i = gt; i < 3 * 128 * 128; i += GT) { const int z = i / (128 * 128), rr = (i / 128) % 128, c = i % 128; *(v4u*)(wl1 + (size_t)(z * 256 + 128 + rr) * 1024 + c * 8) = (v4u){0u, 0u, 0u, 0u}; }
    for (int i = gt; i < 1024 * 16; i += GT) { const int rr = i / 16, c = i % 16; *(v4u*)(g2t + (size_t)rr * 256 + 128 + c * 8) = (v4u){0u, 0u, 0u, 0u}; }
    for (int i = gt; i < (4 * M + 64 * 64) / 4; i += GT) *(f32x4*)((float*)(p.ws + OFF_SSQ) + 4 * i) = (f32x4){0.f, 0.f, 0.f, 0.f};
}
__device__ __forceinline__ void phase_bias(const Params& p, unsigned char* lds, int wi, int nw) {
    float* sc = (float*)lds;
    float* red = sc + 5 * 1024;
    const int tid = threadIdx.x;
    const float* MOD = (const float*)(p.ws + OFF_MOD);
    int cur = -1;
    for (int it = wi; it < 88 + 64 + 88; it += nw) {
        const int which = it < 88 ? 0 : (it < 152 ? 1 : 2);
        const int blk = which == 0 ? it : (which == 1 ? it - 88 : it - 152);
        const int N = which == 1 ? 4096 : F2;
        const float* Wsrc = which == 0 ? p.in[10] : (which == 1 ? p.in[33] : p.in[10] + (size_t)1024 * F2);
        const float* shv = MOD + (which == 0 ? 3 * 1024 : (which == 1 ? 5 * 6144 : 5 * 6144 + 3 * 1024));
        float* outb = (float*)(p.ws + (which == 0 ? BIAS0 : (which == 1 ? BIAS1 : BIAS2)));
        if (which != cur) { __syncthreads(); for (int i = tid; i < 5 * 1024; i += 512) sc[i] = shv[(i >> 10) * 6144 + (i & 1023)]; cur = which; __syncthreads(); }
        const int n0 = blk * 64, ks = tid >> 6, nl = tid & 63;
        const float* W = Wsrc + n0 + nl;
        float a0 = 0.f, a1 = 0.f, a2 = 0.f, a3 = 0.f, a4 = 0.f;
#pragma unroll 32
        for (int k = ks * 128; k < ks * 128 + 128; ++k) { const float w = W[(size_t)k * N];
            a0 += sc[k] * w; a1 += sc[1024 + k] * w; a2 += sc[2048 + k] * w; a3 += sc[3072 + k] * w; a4 += sc[4096 + k] * w; }
        red[(ks * 5 + 0) * 64 + nl] = a0; red[(ks * 5 + 1) * 64 + nl] = a1; red[(ks * 5 + 2) * 64 + nl] = a2; red[(ks * 5 + 3) * 64 + nl] = a3; red[(ks * 5 + 4) * 64 + nl] = a4;
        __syncthreads();
        if (tid < 320) { const int ci = tid >> 6; float sum = 0.f;
#pragma unroll
            for (int q = 0; q < 8; ++q) sum += red[(q * 5 + ci) * 64 + nl];
            outb[(size_t)ci * N + n0 + nl] = sum; }
        __syncthreads();
    }
}
__device__ __forceinline__ void phase_w1(const Params& p, unsigned char* lds) {
    const int tid = threadIdx.x, lane = tid & 63, wave = tid >> 6;
    LAS float* scr = (LAS float*)((LAS unsigned char*)lds) + wave * (64 * 65);
    const int gw = blockIdx.x * 8 + wave, NGW = gridDim.x * 8;
    bf16* dnt = (bf16*)(p.ws + OFF_W + W1_DN);
    constexpr int NITEMS = 44 * 16;
    for (int it = gw; it < NITEMS; it += NGW) {
        int r = it;
        TR_JOB(p.in[13] + (size_t)FH * 1024, FH, 1024, dnt, FH, 0)
    }
}
__device__ __forceinline__ void phase_wlate(const Params& p, unsigned char* lds, int wi, int nw) {
    const int tid = threadIdx.x, lane = tid & 63, wave = tid >> 6;
    LAS float* scr = (LAS float*)((LAS unsigned char*)lds) + wave * (64 * 65);
    const int gw = wi * 8 + wave, NGW = nw * 8;
    unsigned char* WB = p.ws + OFF_W;
    bf16* wo = (bf16*)(WB + W_O); bf16* upt = (bf16*)(WB + W_UP); bf16* dnt = (bf16*)(WB + W_DN);
    bf16* sgin = (bf16*)(p.ws + X_SGIN); bf16* sgout = (bf16*)(p.ws + X_SGOUT); bf16* up1 = (bf16*)(p.ws + X_UP1); bf16* wsb = (bf16*)(p.ws + X_WS);
    constexpr int NITEMS = 256 + 16 * 88 + 44 * 16 + 16 * 64 + 32 * 16 + 16 * 88 + 44 * 16;
    for (int it = gw; it < NITEMS; it += NGW) {
        int r = it;
        TR_JOB(p.in[19], 1024, 1024, wo, 1024, 0)
        TR_JOB(p.in[10], 1024, F2, upt, 1024, 0)
        TR_JOB(p.in[13], FH, 1024, dnt, FH, 0)
        TR_JOB(p.in[33], 1024, 4096, sgin, 1024, 0)
        TR_JOB(p.in[38], E, 1024, sgout, E, 0)
        TR_JOB(p.in[10] + (size_t)1024 * F2, 1024, F2, up1, 1024, 0)
        TR_JOB(p.in[13] + (size_t)FH * 1024, FH, 1024, (bf16*)(WB + W_RKV), FH, 0)
    }
    const int gt = wi * 512 + tid, GT = nw * 512;
    for (int i = gt; i < 8 * 128 * 128 / 4; i += GT) { const f32x4 v = *(const f32x4*)(p.in[36] + (size_t)i * 4); *(v2u*)(wsb + (size_t)i * 4) = pack4(v); }
}

__device__ __forceinline__ const float* xrow_l0(const Params& p, int m) { return m < MP ? p.in[0] + (size_t)m * D : p.in[1] + (size_t)(m - MP) * D; }

__device__ __forceinline__ void phase_mix(const Params& p) {
    const int tid = threadIdx.x, lane = tid & 63, wave = tid >> 6;
    const int gw = blockIdx.x * 8 + wave, NGW = gridDim.x * 8;
    const float* MOD = (const float*)(p.ws + OFF_MOD);
    unsigned char* AB = p.ws + OFF_A;
    for (int m = gw; m < M; m += NGW) {
        const int T = m < MP ? 256 : 2048, t = m < MP ? (m & 255) : ((m - MP) & 2047), ci = cond_of(m);
        const bool okp = t > 0, okn = t < T - 1;
        const f32x4* x1 = (const f32x4*)xrow_l0(p, m) + 2 * lane;
        const f32x4* x0 = (const f32x4*)xrow_l0(p, okp ? m - 1 : m) + 2 * lane;
        const f32x4* x2 = (const f32x4*)xrow_l0(p, okn ? m + 1 : m) + 2 * lane;
        f32x4 a[4], b[4], c[4]; float s0 = 0.f, s1 = 0.f, s2 = 0.f;
#pragma unroll
        for (int j = 0; j < 4; ++j) { const int o = (j >> 1) * 128 + (j & 1); a[j] = x0[o]; b[j] = x1[o]; c[j] = x2[o];
            s0 += (a[j].x * a[j].x + a[j].y * a[j].y) + (a[j].z * a[j].z + a[j].w * a[j].w);
            s1 += (b[j].x * b[j].x + b[j].y * b[j].y) + (b[j].z * b[j].z + b[j].w * b[j].w);
            s2 += (c[j].x * c[j].x + c[j].y * c[j].y) + (c[j].z * c[j].z + c[j].w * c[j].w); }
        const float r0 = okp ? rsqrtf(wave_sum(s0) * (1.f / D) + 1e-6f) : 0.f, r1 = rsqrtf(wave_sum(s1) * (1.f / D) + 1e-6f), r2 = okn ? rsqrtf(wave_sum(s2) * (1.f / D) + 1e-6f) : 0.f;
        const float* sh = MOD + ci * 6144; const float* scp = sh + 1024;
        f32x4 h1[4], dp[4], dn[4];
#pragma unroll
        for (int j = 0; j < 4; ++j) {
            const int col = (j >> 1) * 512 + 8 * lane + (j & 1) * 4;
            const f32x4 g = *(const f32x4*)(p.in[8] + col), sc1 = *(const f32x4*)(scp + col), sh1 = *(const f32x4*)(sh + col);
            const f32x4 gs = g * (sc1 + 1.0f);
            f32x4 h0 = a[j] * r0 * gs + sh1, h2 = c[j] * r2 * gs + sh1; h1[j] = b[j] * r1 * gs + sh1;
            if (!okp) h0 = (f32x4){0.f, 0.f, 0.f, 0.f};
            if (!okn) h2 = (f32x4){0.f, 0.f, 0.f, 0.f};
            dp[j] = h0 - h1[j]; dn[j] = h2 - h1[j];
        }
#pragma unroll
        for (int q = 0; q < 2; ++q) {
            const int col = q * 512 + 8 * lane;
#pragma unroll
            for (int i = 0; i < 6; ++i) {
                const int slot = i == 0 ? 3 : i == 1 ? 0 : i == 2 ? 4 : i == 3 ? 5 : i == 4 ? 1 : 2;
                const float* m0p = p.in[15] + i * 1024 + col; const float* m1p = p.in[15] + (6 + i) * 1024 + col;
                const f32x4 oa = h1[2 * q] + dp[2 * q] * *(const f32x4*)m0p + dn[2 * q] * *(const f32x4*)m1p;
                const f32x4 ob = h1[2 * q + 1] + dp[2 * q + 1] * *(const f32x4*)(m0p + 4) + dn[2 * q + 1] * *(const f32x4*)(m1p + 4);
                v4u w; w.x = pk2(oa.x, oa.y); w.y = pk2(oa.z, oa.w); w.z = pk2(ob.x, ob.y); w.w = pk2(ob.z, ob.w);
                *(v4u*)((bf16*)(AB + slot * SL) + (size_t)m * D + col) = w;
            }
        }
    }
}
__device__ __forceinline__ void phase_norm(const Params& p, const float* gvec, int layer, int shofs, int scofs) {
    const int tid = threadIdx.x, lane = tid & 63, wave = tid >> 6;
    const int gw = blockIdx.x * 8 + wave, NGW = gridDim.x * 8;
    const float* MOD = (const float*)(p.ws + OFF_MOD) + layer * 5 * 6144;
    bf16* H = (bf16*)(p.ws + OFF_A + A_H);
    for (int m = gw; m < M; m += 3 * NGW) {
        f32x4 b[3][4];
#pragma unroll
        for (int k = 0; k < 3; ++k) { const int mm = (m + k * NGW < M) ? m + k * NGW : m; const f32x4* x1 = (const f32x4*)(p.out + (size_t)mm * D) + lane;
#pragma unroll
            for (int j = 0; j < 4; ++j) b[k][j] = x1[64 * j]; }
#pragma unroll
        for (int k = 0; k < 3; ++k) { const int mm = m + k * NGW; if (mm >= M) break;
            const int ci = cond_of(mm); float s1 = 0.f;
#pragma unroll
            for (int j = 0; j < 4; ++j) s1 += (b[k][j].x * b[k][j].x + b[k][j].y * b[k][j].y) + (b[k][j].z * b[k][j].z + b[k][j].w * b[k][j].w);
            const float r1 = rsqrtf(wave_sum(s1) * (1.f / D) + 1e-6f);
#pragma unroll
            for (int j = 0; j < 4; ++j) {
                const int col = 4 * lane + 256 * j;
                const f32x4 g = *(const f32x4*)(gvec + col), sc = *(const f32x4*)(MOD + ci * 6144 + scofs + col), sh = *(const f32x4*)(MOD + ci * 6144 + shofs + col);
                const f32x4 h = b[k][j] * r1 * g * (sc + 1.0f) + sh;
                *(v2u*)(H + (size_t)mm * D + col) = pack4(h);
            } }
    }
}
__device__ __forceinline__ void phase_final(const Params& p) {
    const int tid = threadIdx.x, lane = tid & 63, wave = tid >> 6;
    const int gw = blockIdx.x * 8 + wave, NGW = gridDim.x * 8;
    for (int m = gw; m < M; m += 3 * NGW) {
        f32x4 b[3][4];
#pragma unroll
        for (int k = 0; k < 3; ++k) { const int mm = (m + k * NGW < M) ? m + k * NGW : m; const f32x4* x1 = (const f32x4*)(p.out + (size_t)mm * D) + lane;
#pragma unroll
            for (int j = 0; j < 4; ++j) b[k][j] = x1[64 * j]; }
#pragma unroll
        for (int k = 0; k < 3; ++k) { const int mm = m + k * NGW; if (mm >= M) break;
            float s1 = 0.f;
#pragma unroll
            for (int j = 0; j < 4; ++j) s1 += (b[k][j].x * b[k][j].x + b[k][j].y * b[k][j].y) + (b[k][j].z * b[k][j].z + b[k][j].w * b[k][j].w);
            const float r1 = rsqrtf(wave_sum(s1) * (1.f / D) + 1e-6f);
            f32x4* xo = (f32x4*)(p.out + (size_t)mm * D) + lane;
#pragma unroll
            for (int j = 0; j < 4; ++j) { const f32x4 g = *(const f32x4*)(p.in[14] + 4 * lane + 256 * j); xo[64 * j] = b[k][j] * r1 * g; } }
    }
}

constexpr int VST = 324;
constexpr int TC = 32;
constexpr int SBUF = TC * VST + TC * 64;
#define LO2(v) __builtin_shufflevector(v, v, 0, 1)
#define HI2(v) __builtin_shufflevector(v, v, 2, 3)
__device__ __forceinline__ void scan_prep(const Params& p, float* buf, int mrow0, int tile, int h, int d, int lane) {
    const int fr = lane & 15, fq = lane >> 4;
    unsigned char* AB = p.ws + OFF_A;
    const bf16* Rb = (const bf16*)(AB + 0 * SL); const bf16* Kb = (const bf16*)(AB + 1 * SL); const bf16* Vb = (const bf16*)(AB + 2 * SL);
    const bf16* L1 = (const bf16*)(AB + A_L1);
    const bf16* W2T = (const bf16*)(p.ws + OFF_W + W_W2); const bf16* A2T = (const bf16*)(p.ws + OFF_W + W_A2);
    float* BONd = (float*)(p.ws + OFF_BON) + (size_t)d * M * 16;
    float* VEC = buf; float* VV = buf + TC * VST;
    const int tl = 16 * tile + fr; const size_t m = (size_t)(mrow0 + tl);
    const bf16* l1row = L1 + m * 512 + d * 64;
    const bf16x8 yw0 = *(const bf16x8*)(l1row + 8 * fq), yw1 = *(const bf16x8*)(l1row + 32 + 8 * fq);
    const bf16x8 ya0 = *(const bf16x8*)(l1row + 128 + 8 * fq), ya1 = *(const bf16x8*)(l1row + 160 + 8 * fq);
    f32x4 dec[4], asg[4], kkr[4], kd[4], rr[4];
    float ss = 0.f, bon = 0.f;
#pragma unroll
    for (int nt = 0; nt < 4; ++nt) {
        const size_t wro = ((size_t)(d * 1024 + h * 64 + nt * 16 + fr)) * 64;
        const bf16x8 xw0 = *(const bf16x8*)(W2T + wro + 8 * fq), xw1 = *(const bf16x8*)(W2T + wro + 32 + 8 * fq);
        const bf16x8 xa0 = *(const bf16x8*)(A2T + wro + 8 * fq), xa1 = *(const bf16x8*)(A2T + wro + 32 + 8 * fq);
        f32x4 aw = (f32x4){0.f, 0.f, 0.f, 0.f}, aa = (f32x4){0.f, 0.f, 0.f, 0.f};
        aw = __builtin_amdgcn_mfma_f32_16x16x32_bf16(xw0, yw0, aw, 0, 0, 0); aw = __builtin_amdgcn_mfma_f32_16x16x32_bf16(xw1, yw1, aw, 0, 0, 0);
        aa = __builtin_amdgcn_mfma_f32_16x16x32_bf16(xa0, ya0, aa, 0, 0, 0); aa = __builtin_amdgcn_mfma_f32_16x16x32_bf16(xa1, ya1, aa, 0, 0, 0);
        const int hjg = h * 64 + nt * 16 + 4 * fq;
        const f32x4 kv = unpack4(*(const v2u*)(Kb + m * D + hjg)), rv = unpack4(*(const v2u*)(Rb + m * D + hjg)), vv = unpack4(*(const v2u*)(Vb + m * D + hjg));
        const f32x4 w0 = *(const f32x4*)(p.in[20] + d * 1024 + hjg), a0 = *(const f32x4*)(p.in[23] + d * 1024 + hjg);
        const f32x4 k_k = *(const f32x4*)(p.in[28] + hjg), k_a = *(const f32x4*)(p.in[29] + hjg), r_k = *(const f32x4*)(p.in[30] + hjg);
#pragma unroll
        for (int j = 0; j < 4; ++j) {
            const float wr_ = aw[j] + w0[j];
            dec[nt][j] = __expf(-0.6065306597126334f * __builtin_amdgcn_rcpf(1.0f + __expf(-wr_)));
            const float as_ = __builtin_amdgcn_rcpf(1.0f + __expf(-(aa[j] + a0[j])));
            asg[nt][j] = as_;
            const float kr = kv[j] * k_k[j]; kkr[nt][j] = kr; ss += kr * kr;
            const float kd_ = kv[j] * (1.0f + (as_ - 1.0f) * k_a[j]); kd[nt][j] = kd_;
            bon += rv[j] * kd_ * r_k[j];
        }
        rr[nt] = rv;
        *(f32x4*)(VV + tl * 64 + nt * 16 + 4 * fq) = vv;
    }
    ss += __shfl_xor(ss, 16); ss += __shfl_xor(ss, 32);
    bon += __shfl_xor(bon, 16); bon += __shfl_xor(bon, 32);
    const float inv = 1.0f / fmaxf(sqrtf(ss), 1e-12f);
    float* vrow = VEC + tl * VST;
#pragma unroll
    for (int nt = 0; nt < 4; ++nt) {
        const int jj = nt * 16 + 4 * fq;
        const f32x4 kk = kkr[nt] * inv;
        *(f32x4*)(vrow + jj) = dec[nt];
        *(f32x4*)(vrow + 64 + jj) = kd[nt];
        *(f32x4*)(vrow + 128 + jj) = -kk;
        *(f32x4*)(vrow + 192 + jj) = kk * asg[nt];
        *(f32x4*)(vrow + 256 + jj) = rr[nt];
    }
    if (fq == 0) BONd[m * 16 + h] = bon;
}
#define SC_LOADV(X, tl_) { const float* vp_ = VEC + (tl_) * VST + j0; \
    X##w0 = *(const f32x4*)(vp_); X##w1 = *(const f32x4*)(vp_ + 4); X##k0 = *(const f32x4*)(vp_ + 64); X##k1 = *(const f32x4*)(vp_ + 68); \
    X##a0 = *(const f32x4*)(vp_ + 128); X##a1 = *(const f32x4*)(vp_ + 132); X##b0 = *(const f32x4*)(vp_ + 192); X##b1 = *(const f32x4*)(vp_ + 196); \
    X##r0 = *(const f32x4*)(vp_ + 256); X##r1 = *(const f32x4*)(vp_ + 260); X##v = *(const f32x2*)(VV + (tl_) * 64 + i0); }
#define SC_STEP(X, tl_) { \
    f32x2 p0_ = S0[0] * LO2(X##a0), p1_ = S1[0] * LO2(X##a0); \
    p0_ = __builtin_elementwise_fma(S0[1], HI2(X##a0), p0_); p1_ = __builtin_elementwise_fma(S1[1], HI2(X##a0), p1_); \
    p0_ = __builtin_elementwise_fma(S0[2], LO2(X##a1), p0_); p1_ = __builtin_elementwise_fma(S1[2], LO2(X##a1), p1_); \
    p0_ = __builtin_elementwise_fma(S0[3], HI2(X##a1), p0_); p1_ = __builtin_elementwise_fma(S1[3], HI2(X##a1), p1_); \
    const f32x2 v0v_ = (f32x2){X##v.x, X##v.x}, v1v_ = (f32x2){X##v.y, X##v.y}; \
    f32x2 t00_ = __builtin_elementwise_fma(v0v_, LO2(X##k0), S0[0] * LO2(X##w0)), t01_ = __builtin_elementwise_fma(v0v_, HI2(X##k0), S0[1] * HI2(X##w0)); \
    f32x2 t02_ = __builtin_elementwise_fma(v0v_, LO2(X##k1), S0[2] * LO2(X##w1)), t03_ = __builtin_elementwise_fma(v0v_, HI2(X##k1), S0[3] * HI2(X##w1)); \
    f32x2 t10_ = __builtin_elementwise_fma(v1v_, LO2(X##k0), S1[0] * LO2(X##w0)), t11_ = __builtin_elementwise_fma(v1v_, HI2(X##k0), S1[1] * HI2(X##w0)); \
    f32x2 t12_ = __builtin_elementwise_fma(v1v_, LO2(X##k1), S1[2] * LO2(X##w1)), t13_ = __builtin_elementwise_fma(v1v_, HI2(X##k1), S1[3] * HI2(X##w1)); \
    const float sa0_ = red8s(p0_.x + p0_.y), sa1_ = red8s(p1_.x + p1_.y); \
    const f32x2 sa0v_ = (f32x2){sa0_, sa0_}, sa1v_ = (f32x2){sa1_, sa1_}; \
    S0[0] = __builtin_elementwise_fma(sa0v_, LO2(X##b0), t00_); S0[1] = __builtin_elementwise_fma(sa0v_, HI2(X##b0), t01_); \
    S0[2] = __builtin_elementwise_fma(sa0v_, LO2(X##b1), t02_); S0[3] = __builtin_elementwise_fma(sa0v_, HI2(X##b1), t03_); \
    S1[0] = __builtin_elementwise_fma(sa1v_, LO2(X##b0), t10_); S1[1] = __builtin_elementwise_fma(sa1v_, HI2(X##b0), t11_); \
    S1[2] = __builtin_elementwise_fma(sa1v_, LO2(X##b1), t12_); S1[3] = __builtin_elementwise_fma(sa1v_, HI2(X##b1), t13_); \
    f32x2 y0_ = S0[0] * LO2(X##r0), y1_ = S1[0] * LO2(X##r0); \
    y0_ = __builtin_elementwise_fma(S0[1], HI2(X##r0), y0_); y1_ = __builtin_elementwise_fma(S1[1], HI2(X##r0), y1_); \
    y0_ = __builtin_elementwise_fma(S0[2], LO2(X##r1), y0_); y1_ = __builtin_elementwise_fma(S1[2], LO2(X##r1), y1_); \
    y0_ = __builtin_elementwise_fma(S0[3], HI2(X##r1), y0_); y1_ = __builtin_elementwise_fma(S1[3], HI2(X##r1), y1_); \
    const float yy0_ = red8s(y0_.x + y0_.y), yy1_ = red8s(y1_.x + y1_.y); \
    *(unsigned*)(Yrow + (size_t)(tl_) * D) = pg8::cvt_pk_bf16(yy0_, yy1_); }

__device__ __forceinline__ void scan_unit(const Params& p, unsigned char* lds, int u) {
    const int tid = threadIdx.x, lane = tid & 63, wave = __builtin_amdgcn_readfirstlane(tid >> 6);
    int b, h, d, T, m0;
    if (u < 128) { b = u >> 5; h = (u >> 1) & 15; d = u & 1; T = 2048; m0 = MP + b * 2048; }
    else { const int v = u - 128; b = v >> 5; h = (v >> 1) & 15; d = v & 1; T = 256; m0 = b * 256; }
    float* BUF = (float*)lds;
    bf16* Yd = (bf16*)(p.ws + OFF_A + (3 + d) * SL);
    const int rp = lane >> 3, cgp = lane & 7, i0 = 16 * wave + 2 * rp, j0 = 8 * cgp;
    f32x2 S0[4], S1[4];
#pragma unroll
    for (int q = 0; q < 4; ++q) { S0[q] = (f32x2){0.f, 0.f}; S1[q] = (f32x2){0.f, 0.f}; }
    if (wave < 4 && u < 128) {
        const float* s0 = (d ? p.in[3] : p.in[2]) + (size_t)(b * 16 + h) * 4096 + (size_t)i0 * 64 + j0;
#pragma unroll
        for (int q = 0; q < 4; ++q) { S0[q] = *(const f32x2*)(s0 + 2 * q); S1[q] = *(const f32x2*)(s0 + 64 + 2 * q); }
    }
    const int nch = T / TC;
    if (wave == 4 || wave == 5) scan_prep(p, BUF, m0 + (d ? nch - 1 : 0) * TC, wave - 4, h, d, lane);
    __syncthreads();
    for (int ch = 0; ch < nch; ++ch) {
        const int tb = (d ? nch - 1 - ch : ch) * TC;
        if (wave < 4) {
            const float* VEC = BUF + (ch & 1) * SBUF; const float* VV = VEC + TC * VST;
            bf16* Yrow = Yd + (size_t)(m0 + tb) * D + h * 64 + i0;
            int tl = d ? TC - 1 : 0; const int dt = d ? -1 : 1;
            f32x4 Aw0, Aw1, Ak0, Ak1, Aa0, Aa1, Ab0, Ab1, Ar0, Ar1; f32x2 Av;
            f32x4 Bw0, Bw1, Bk0, Bk1, Ba0, Ba1, Bb0, Bb1, Br0, Br1; f32x2 Bv;
            SC_LOADV(A, tl)
#pragma unroll 1
            for (int s = 0; s < TC; s += 2) {
                SC_LOADV(B, tl + dt)
                SC_STEP(A, tl)
                const int t2 = (s + 2 < TC) ? tl + 2 * dt : tl + dt;
                SC_LOADV(A, t2)
                SC_STEP(B, tl + dt)
                tl += 2 * dt;
            }
        } else if ((wave == 4 || wave == 5) && ch + 1 < nch) {
            scan_prep(p, BUF + ((ch + 1) & 1) * SBUF, m0 + (d ? nch - 2 - ch : ch + 1) * TC, wave - 4, h, d, lane);
        }
        __syncthreads();
    }
    if (wave < 4 && u >= 128) {
        float* so = p.out + (size_t)M * D + (size_t)d * (16 * 16 * 4096) + (size_t)(b * 16 + h) * 4096 + (size_t)i0 * 64 + j0;
#pragma unroll
        for (int q = 0; q < 4; ++q) { *(f32x2*)(so + 2 * q) = S0[q]; *(f32x2*)(so + 64 + 2 * q) = S1[q]; }
    }
}
__device__ __forceinline__ void phase_scan(const Params& p, unsigned char* lds) {
    const int c = blockIdx.x, G = gridDim.x;
    int u0, nu, ust, wi, nw; bool late;
    if (G == 256) { if (c < 128) { u0 = c; nu = 1; ust = 1; late = false; wi = 0; nw = 1; } else { u0 = 128 + (c - 128) * 4; nu = 4; ust = 1; late = true; wi = c - 128; nw = 128; } }
    else { u0 = c; ust = G; nu = (640 - c + G - 1) / G; late = true; wi = c; nw = G; }
#pragma unroll 1
    for (int k = 0; k < nu; ++k) scan_unit(p, lds, u0 + k * ust);
    if (late) {
        __syncthreads(); phase_wlate(p, lds, wi, nw);
        __syncthreads(); phase_bias(p, lds, wi, nw);
        __syncthreads();
        unsigned char* AB = p.ws + OFF_A; unsigned char* WB = p.ws + OFF_W;
        pg8::Gemm g{(const bf16*)(AB + A_L1) + 256, (const bf16*)(WB + W_G2), 512, 256, 256, 0, 0};
        pg8::Order S; S.init(M / 192, 4, 1, nw, wi);
        pg8::EpiBf16<0, 3> Ep{(bf16*)(AB + A_G), D, 0, 0, 0};
        pg8::gemm_phase<pg8::EpiBf16<0, 3>, 3>((PG8_LAS unsigned char*)lds, g, S, Ep);
    }
}
__device__ __forceinline__ void phase_post(const Params& p) {
    const int tid = threadIdx.x, lane = tid & 63, wave = tid >> 6;
    const int gw = blockIdx.x * 8 + wave, NGW = gridDim.x * 8;
    unsigned char* AB = p.ws + OFF_A;
    const bf16* Vb = (const bf16*)(AB + 2 * SL); const bf16* Y0 = (const bf16*)(AB + 3 * SL); const bf16* Y1 = (const bf16*)(AB + 4 * SL); const bf16* Gb = (const bf16*)(AB + A_G);
    bf16* Z = (bf16*)(AB + 5 * SL);
    const float* BON = (const float*)(p.ws + OFF_BON);
    const int c0 = 16 * lane, hh = lane >> 2;
    f32x4 lwv[4], lbv[4];
#pragma unroll
    for (int q = 0; q < 4; ++q) { lwv[q] = *(const f32x4*)(p.in[31] + c0 + 4 * q); lbv[q] = *(const f32x4*)(p.in[32] + c0 + 4 * q); }
    for (int mb = gw; mb < M; mb += 2 * NGW) {
        v4u ra[2][2], rb[2][2], rv[2][2], rg[2][2]; float bonv[2];
#pragma unroll
        for (int k = 0; k < 2; ++k) { const int m = (mb + k * NGW < M) ? mb + k * NGW : mb; const size_t ro = (size_t)m * D + c0;
#pragma unroll
            for (int q = 0; q < 2; ++q) { ra[k][q] = *(const v4u*)(Y0 + ro + 8 * q); rb[k][q] = *(const v4u*)(Y1 + ro + 8 * q); rv[k][q] = *(const v4u*)(Vb + ro + 8 * q); rg[k][q] = *(const v4u*)(Gb + ro + 8 * q); }
            bonv[k] = BON[(size_t)m * 16 + hh] + BON[(size_t)M * 16 + (size_t)m * 16 + hh]; }
#pragma unroll
        for (int k = 0; k < 2; ++k) { const int m = mb + k * NGW; if (m >= M) break;
            const size_t ro = (size_t)m * D + c0;
            float y[16], v[16], g[16];
#pragma unroll
            for (int q = 0; q < 2; ++q) {
                const unsigned aw[4] = {ra[k][q].x, ra[k][q].y, ra[k][q].z, ra[k][q].w}, bw[4] = {rb[k][q].x, rb[k][q].y, rb[k][q].z, rb[k][q].w};
                const unsigned vw[4] = {rv[k][q].x, rv[k][q].y, rv[k][q].z, rv[k][q].w}, gw_[4] = {rg[k][q].x, rg[k][q].y, rg[k][q].z, rg[k][q].w};
#pragma unroll
                for (int j = 0; j < 4; ++j) { y[8 * q + 2 * j] = bflo(aw[j]) + bflo(bw[j]); y[8 * q + 2 * j + 1] = bfhi(aw[j]) + bfhi(bw[j]);
                    v[8 * q + 2 * j] = bflo(vw[j]); v[8 * q + 2 * j + 1] = bfhi(vw[j]); g[8 * q + 2 * j] = bflo(gw_[j]); g[8 * q + 2 * j + 1] = bfhi(gw_[j]); }
            }
            float s_ = 0.f;
#pragma unroll
            for (int j = 0; j < 16; ++j) s_ += y[j];
            const float mean = red4(s_) * (1.f / 64.f);
            float q2 = 0.f;
#pragma unroll
            for (int j = 0; j < 16; ++j) { const float dd = y[j] - mean; q2 += dd * dd; }
            const float rstd = rsqrtf(red4(q2) * (1.f / 64.f) + 64e-5f);
            const float bon = bonv[k];
            unsigned o[8];
#pragma unroll
            for (int j = 0; j < 16; j += 2) {
                const float lw0 = lwv[j >> 2][j & 3], lw1 = lwv[j >> 2][(j & 3) + 1], lb0 = lbv[j >> 2][j & 3], lb1 = lbv[j >> 2][(j & 3) + 1];
                const float z0 = ((y[j] - mean) * rstd * lw0 + lb0 + bon * v[j]) * g[j];
                const float z1 = ((y[j + 1] - mean) * rstd * lw1 + lb1 + bon * v[j + 1]) * g[j + 1];
                o[j >> 1] = pk2(z0, z1);
            }
            *(v4u*)(Z + ro) = (v4u){o[0], o[1], o[2], o[3]};
            *(v4u*)(Z + ro + 8) = (v4u){o[4], o[5], o[6], o[7]};
        }
    }
}

template <bool GRID>
__device__ __forceinline__ void conv_item(const bf16* UPp, bf16* ACT, const float* wc, const float* bc, int f, int mline, bool up_ok, bool dn_ok, bool l_ok, bool r_ok) {
    constexpr int NR = GRID ? 3 : 1, R0 = GRID ? 0 : 1;
    f32x4 wv[NR][3], wg[NR][3];
#pragma unroll
    for (int r = 0; r < NR; ++r)
#pragma unroll
        for (int dx = 0; dx < 3; ++dx) { wv[r][dx] = *(const f32x4*)(wc + ((R0 + r) * 3 + dx) * F2 + f); wg[r][dx] = *(const f32x4*)(wc + ((R0 + r) * 3 + dx) * F2 + FH + f); }
    const f32x4 bv = *(const f32x4*)(bc + f), bg = *(const f32x4*)(bc + FH + f);
    v2u Pv[6][NR], Pg[6][NR];
#define CONV_LD(col_, mtok_, ok_) { _Pragma("unroll") for (int r = 0; r < NR; ++r) { \
        const bool rok_ = (ok_) && (!GRID || r == 1 || (r == 0 ? up_ok : dn_ok)); \
        if (rok_) { const bf16* pr_ = UPp + (size_t)((mtok_) + (GRID ? (r - 1) * 64 : 0)) * F2 + f; Pv[col_][r] = *(const v2u*)pr_; Pg[col_][r] = *(const v2u*)(pr_ + FH); } \
        else { Pv[col_][r] = (v2u){0u, 0u}; Pg[col_][r] = (v2u){0u, 0u}; } } }
    CONV_LD(0, mline - 1, l_ok)
    CONV_LD(1, mline, true)
#pragma unroll 1
    for (int x0 = 0; x0 < 64; x0 += 4) {
#pragma unroll
        for (int k = 0; k < 4; ++k) CONV_LD(2 + k, mline + x0 + 1 + k, (x0 + 1 + k < 64) || r_ok)
#pragma unroll
        for (int xx = 0; xx < 4; ++xx) {
            f32x4 av = bv, ag = bg;
#pragma unroll
            for (int r = 0; r < NR; ++r)
#pragma unroll
                for (int dx = 0; dx < 3; ++dx) { av += unpack4(Pv[xx + dx][r]) * wv[r][dx]; ag += unpack4(Pg[xx + dx][r]) * wg[r][dx]; }
            f32x4 o;
#pragma unroll
            for (int j = 0; j < 4; ++j) o[j] = ag[j] * __builtin_amdgcn_rcpf(1.0f + __expf(-ag[j])) * av[j];
            v2u ow; ow.x = pg8::cvt_pk_bf16(o[0], o[1]); ow.y = pg8::cvt_pk_bf16(o[2], o[3]);
            *(v2u*)(ACT + (size_t)(mline + x0 + xx) * FH + f) = ow;
        }
#pragma unroll
        for (int r = 0; r < NR; ++r) { Pv[0][r] = Pv[4][r]; Pg[0][r] = Pg[4][r]; Pv[1][r] = Pv[5][r]; Pg[1][r] = Pg[5][r]; }
    }
#undef CONV_LD
}
__device__ __forceinline__ void phase_conv(const Params& p, int layer) {
    const bf16* UPp = (const bf16*)(p.ws + OFF_A + A_UP); bf16* ACT = (bf16*)(p.ws + OFF_A + A_ACT);
    const float* wc = p.in[11] + (size_t)layer * 9 * F2; const float* bc = p.in[12] + (size_t)layer * F2;
    constexpr int NS = 4 * 32 * 704, NP = 16 * 4 * 704;
    const int lane = threadIdx.x & 63, wave = threadIdx.x >> 6, c = blockIdx.x;
    if (gridDim.x == 256) {
        if (c < 176) { const int b = c / 44, rem = c % 44, yg = rem / 11, qb = rem % 11, y = yg * 8 + wave, q = qb * 64 + lane;
            conv_item<true>(UPp, ACT, wc, bc, 4 * q, MP + b * 2048 + y * 64, y > 0, y < 31, false, false); }
        else { for (int iw = (c - 176) * 8 + wave; iw < NP / 64; iw += 80 * 8) { const int j = iw * 64 + lane, q = j % 704, r = j / 704, seg = r & 3, b = r >> 2;
            conv_item<false>(UPp, ACT, wc, bc, 4 * q, b * 256 + seg * 64, false, false, seg > 0, seg < 3); } }
        return;
    }
    for (int iw = blockIdx.x + gridDim.x * wave; iw < (NS + NP) / 64; iw += gridDim.x * 8) {
        const int it = iw * 64 + lane;
        if (it < NS) { const int q = it % 704, r = it / 704, y = r & 31, b = r >> 5;
            conv_item<true>(UPp, ACT, wc, bc, 4 * q, MP + b * 2048 + y * 64, y > 0, y < 31, false, false); }
        else { const int j = it - NS, q = j % 704, r = j / 704, seg = r & 3, b = r >> 2;
            conv_item<false>(UPp, ACT, wc, bc, 4 * q, b * 256 + seg * 64, false, false, seg > 0, seg < 3); }
    }
}

constexpr int TQ = 258;
constexpr int WSQ = 136;
__device__ __forceinline__ void phase_sgu_stats(const Params& p) {
    const int tid = threadIdx.x, lane = tid & 63, wave = tid >> 6;
    const int gw = blockIdx.x * 8 + wave, NGW = gridDim.x * 8;
    const bf16* V = (const bf16*)(p.ws + OFF_A + A_V);
    f32x2* STAT = (f32x2*)(p.ws + OFF_BON);
    for (int m = gw; m < M; m += 3 * NGW) {
        v4u a[3][4];
#pragma unroll
        for (int k = 0; k < 3; ++k) { const int mm = m + k * NGW;
#pragma unroll
            for (int j = 0; j < 4; ++j) a[k][j] = (mm < M) ? *(const v4u*)(V + (size_t)mm * E + (j * 64 + lane) * 8) : (v4u){0u, 0u, 0u, 0u}; }
#pragma unroll
        for (int k = 0; k < 3; ++k) { const int mm = m + k * NGW;
            float s = 0.f, s2 = 0.f;
#pragma unroll
            for (int j = 0; j < 4; ++j) { const unsigned aw[4] = {a[k][j].x, a[k][j].y, a[k][j].z, a[k][j].w};
#pragma unroll
                for (int e = 0; e < 4; ++e) { const float x0 = bflo(aw[e]), x1 = bfhi(aw[e]); s += x0 + x1; s2 += x0 * x0 + x1 * x1; } }
            s = wave_sum(s); s2 = wave_sum(s2);
            const float mean = s * (1.f / E), var = fmaxf(s2 * (1.f / E) - mean * mean, 0.f);
            if (lane == 0 && mm < M) STAT[mm] = (f32x2){mean, rsqrtf(var + 1e-5f)};
        }
    }
}
__device__ __forceinline__ void phase_sgu(const Params& p, unsigned char* lds) {
    const int tid = threadIdx.x, lane = tid & 63, wave = tid >> 6, fr = lane & 15, fq = lane >> 4;
    bf16* Tl = (bf16*)lds;
    bf16* WSl = (bf16*)(lds + 128 * TQ * 2);
    bf16* U = (bf16*)(p.ws + OFF_A + A_U); const bf16* V = (const bf16*)(p.ws + OFF_A + A_V);
    const bf16* WSb = (const bf16*)(p.ws + X_WS);
    const f32x2* STAT = (const f32x2*)(p.ws + OFF_BON);
    int gcur = -1;
    for (int it = blockIdx.x; it < 96 * 8; it += gridDim.x) {
        const int n = it >> 3, g = it & 7, m0 = n * 128;
        v4u tv[8];
#pragma unroll
        for (int i = 0; i < 8; ++i) { const int q = (tid >> 5) + 16 * i, c8 = (tid & 31) * 8; tv[i] = *(const v4u*)(V + (size_t)(m0 + q) * E + g * 256 + c8); }
        if (g != gcur) {
#pragma unroll
            for (int i = 0; i < 4; ++i) { const int idx = tid + 512 * i, pr = idx >> 4, qc = (idx & 15) * 8;
                *(v4u*)(WSl + pr * WSQ + qc) = *(const v4u*)(WSb + (size_t)g * 16384 + pr * 128 + qc); }
            gcur = g;
        }
        { const int c8 = (tid & 31) * 8;
          const f32x4 lw0 = *(const f32x4*)(p.in[34] + g * 256 + c8), lw1 = *(const f32x4*)(p.in[34] + g * 256 + c8 + 4);
          const f32x4 lb0 = *(const f32x4*)(p.in[35] + g * 256 + c8), lb1 = *(const f32x4*)(p.in[35] + g * 256 + c8 + 4);
#pragma unroll
          for (int i = 0; i < 8; ++i) {
            const int q = (tid >> 5) + 16 * i;
            const unsigned aw[4] = {tv[i].x, tv[i].y, tv[i].z, tv[i].w};
            const f32x2 st = STAT[m0 + q]; const float mean = st.x * (1.f / E), rstd = rsqrtf(fmaxf(st.y * (1.f / E) - mean * mean, 0.f) + 1e-5f);
            unsigned* dst = (unsigned*)(Tl + q * TQ + c8);
            dst[0] = pk2((bflo(aw[0]) - mean) * rstd * lw0.x + lb0.x, (bfhi(aw[0]) - mean) * rstd * lw0.y + lb0.y);
            dst[1] = pk2((bflo(aw[1]) - mean) * rstd * lw0.z + lb0.z, (bfhi(aw[1]) - mean) * rstd * lw0.w + lb0.w);
            dst[2] = pk2((bflo(aw[2]) - mean) * rstd * lw1.x + lb1.x, (bfhi(aw[2]) - mean) * rstd * lw1.y + lb1.y);
            dst[3] = pk2((bflo(aw[3]) - mean) * rstd * lw1.z + lb1.z, (bfhi(aw[3]) - mean) * rstd * lw1.w + lb1.w);
          } }
        v2u uv[8][2];
#pragma unroll
        for (int pt = 0; pt < 8; ++pt)
#pragma unroll
            for (int ct = 0; ct < 2; ++ct) uv[pt][ct] = *(const v2u*)(U + (size_t)(m0 + pt * 16 + fr) * E + g * 256 + (2 * wave + ct) * 16 + 4 * fq);
        __syncthreads();
        bf16x8 Xf[2][4];
#pragma unroll
        for (int ct = 0; ct < 2; ++ct)
#pragma unroll
            for (int kb = 0; kb < 4; ++kb) { const bf16* src = Tl + (kb * 32 + 8 * fq) * TQ + (2 * wave + ct) * 16 + fr; bf16x8 x;
#pragma unroll
                for (int e = 0; e < 8; ++e) x[e] = (short)src[e * TQ];
                Xf[ct][kb] = x; }
        const float* bs = p.in[37] + g * 128;
#pragma unroll
        for (int pt = 0; pt < 8; ++pt) {
            bf16x8 Yf[4];
#pragma unroll
            for (int kb = 0; kb < 4; ++kb) Yf[kb] = *(const bf16x8*)(WSl + (pt * 16 + fr) * WSQ + kb * 32 + 8 * fq);
            const int pp = pt * 16 + fr; const float bias = bs[pp];
#pragma unroll
            for (int ct = 0; ct < 2; ++ct) {
                f32x4 acc = (f32x4){0.f, 0.f, 0.f, 0.f};
#pragma unroll
                for (int kb = 0; kb < 4; ++kb) acc = __builtin_amdgcn_mfma_f32_16x16x32_bf16(Xf[ct][kb], Yf[kb], acc, 0, 0, 0);
                bf16* up = U + (size_t)(m0 + pp) * E + g * 256 + (2 * wave + ct) * 16 + 4 * fq;
                *(v2u*)up = pack4(unpack4(uv[pt][ct]) * (acc + bias));
            }
        }
        __syncthreads();
    }
}

__global__ void __launch_bounds__(512) mk_fwd(Params p) {
    extern __shared__ __attribute__((aligned(16))) unsigned char lds[];
    cg::grid_group grid = cg::this_grid();
    const int lo = p.ph_lo, hi = p.ph_hi, G = gridDim.x, c = blockIdx.x;
    PG8_LAS unsigned char* glds = (PG8_LAS unsigned char*)lds;
    unsigned char* WB = p.ws + OFF_W; unsigned char* AB = p.ws + OFF_A;
    const float* MOD = (const float*)(p.ws + OFF_MOD);
    volatile LAS unsigned* misc = (volatile LAS unsigned*)((LAS unsigned char*)lds + (LDS_BYTES - 64));
    if (threadIdx.x < 2) misc[threadIdx.x] = 0u;
    __syncthreads();
    XcdBarrier xbar; xbar.bar = (unsigned*)(p.ws + OFF_BAR); xbar.x = 0; xbar.st = misc;
    if (hi - lo > 1) xbar = xcd_barrier_post((unsigned*)(p.ws + OFF_BAR), misc);
    if (lo < 0) grid.sync();
#ifdef ONLY
#define EN(k) (((ONLY) >> (k)) & 1)
#else
#define EN(k) 1
#endif
#define IN(k) (EN(k) && lo <= (k) && (k) < hi)
#define REP(k) _Pragma("unroll 1") for (int rep_ = 0; rep_ < 1 + ((REPMASK >> (k)) & 1); ++rep_)
#define SEAM(k) do { if (lo <= (k) && (k) + 1 < hi) xcd_barrier(xbar); } while (0)
    if (IN(0)) REP(0) { phase_mod(p, lds); __syncthreads(); phase_w0(p, lds); }
    SEAM(0);
    if (IN(1)) REP(1) phase_mix(p);
    SEAM(1);
    if (IN(2)) REP(2) {
        pg8::Gemm g{(const bf16*)AB, (const bf16*)(WB + W_L1), D, D, D, SL, (size_t)256 * 1024 * 2};
        pg8::Order S; S.init(M / 256, 1, 3, G, c);
        pg8::EpiL1 Ep{(bf16*)(AB + A_L1)};
        pg8::gemm_phase(glds, g, S, Ep);
    }
    SEAM(2);
    if (IN(3)) REP(3) {
        { pg8::Gemm g{(const bf16*)(AB + 3 * SL), (const bf16*)(WB + W_RKV), D, D, D, SL, (size_t)1024 * 1024 * 2};
          pg8::Order S; S.init(M / 192, 4, 3, G, c);
          pg8::EpiBf16<0, 3> Ep{(bf16*)AB, D, (size_t)M * D, 0, 0};
          pg8::gemm_phase<pg8::EpiBf16<0, 3>, 3>(glds, g, S, Ep); }
    }
    SEAM(3);
    if (IN(4)) REP(4) phase_scan(p, lds);
    SEAM(4);
    if (IN(5)) phase_post(p);
    SEAM(5);
    float* SSQ = (float*)(p.ws + OFF_SSQ);
    if (IN(6)) {
        pg8::Gemm g{(const bf16*)(AB + 5 * SL), (const bf16*)(WB + W_O), D, D, D, 0, 0};
        pg8::Order S; S.init(M / 192, 4, 1, G, c);
        pg8::EpiRes2 Ep{p.in[0], p.in[1], p.out, MOD + 2 * 1024, (bf16*)(AB + A_H), p.in[9], MOD + 4 * 1024, SSQ};
        pg8::gemm_phase<pg8::EpiRes2, 3>(glds, g, S, Ep);
    }
    SEAM(6);
    if (IN(8)) {
        pg8::Gemm g{(const bf16*)(AB + A_H), (const bf16*)(WB + W_UP), D, D, D, 0, 0};
        pg8::Order S; S.init(M / 256, F2 / 256, 1, G, c);
        pg8::EpiBf16R<0> Ep{(bf16*)(AB + A_UP), F2, 0, 0, SSQ, (const float*)(p.ws + BIAS0), F2, nullptr};
        pg8::gemm_phase(glds, g, S, Ep);
    }
    SEAM(8);
    if (IN(9)) { phase_conv(p, 0); { const int gt_ = blockIdx.x * 512 + threadIdx.x; for (int i = gt_; i < 2 * M / 4; i += gridDim.x * 512) *(f32x4*)((float*)(p.ws + OFF_BON) + 4 * i) = (f32x4){0.f, 0.f, 0.f, 0.f}; } }
    SEAM(9);
    if (IN(10)) {
        pg8::Gemm g{(const bf16*)(AB + A_ACT), (const bf16*)(WB + W_DN), FH, FH, FH, 0, 0};
        pg8::Order S; S.init(M / 192, 4, 1, G, c);
        pg8::EpiRes2 Ep{p.out, p.out + (size_t)MP * D, p.out, MOD + 5 * 1024, (bf16*)(AB + A_H2), p.in[8] + 1024, MOD + 5 * 6144 + 1024, SSQ + M};
        pg8::gemm_phase<pg8::EpiRes2, 3>(glds, g, S, Ep);
    }
    SEAM(10);
    if (IN(12)) {
        pg8::Gemm g{(const bf16*)(AB + A_H2), (const bf16*)(p.ws + X_SGIN), D, D, D, 0, 0};
        pg8::Order S; S.init(M / 256, 16, 1, G, c);
        pg8::EpiBf16R<1> Ep{(bf16*)(AB + A_U), E, E, (size_t)(A_V - A_U) / 2, SSQ + M, (const float*)(p.ws + BIAS1), 4096, (float*)(p.ws + OFF_BON)};
        pg8::gemm_phase(glds, g, S, Ep);
    }
    SEAM(12);
    if (IN(13)) phase_sgu(p, lds);
    SEAM(13);
    if (IN(14)) {
        pg8::Gemm g{(const bf16*)(AB + A_U), (const bf16*)(p.ws + X_SGOUT), E, E, E, 0, 0};
        pg8::Order S; S.init(M / 192, 4, 1, G, c);
        pg8::EpiRes2 Ep{p.out, p.out + (size_t)MP * D, p.out, MOD + 5 * 6144 + 2 * 1024, (bf16*)(AB + A_H), p.in[9] + 1024, MOD + 5 * 6144 + 4 * 1024, SSQ + 2 * M};
        pg8::gemm_phase<pg8::EpiRes2, 3>(glds, g, S, Ep);
    }
    SEAM(14);
    if (IN(16)) {
        pg8::Gemm g{(const bf16*)(AB + A_H), (const bf16*)(p.ws + X_UP1), D, D, D, 0, 0};
        pg8::Order S; S.init(M / 256, F2 / 256, 1, G, c);
        pg8::EpiBf16R<0> Ep{(bf16*)(AB + A_UP), F2, 0, 0, SSQ + 2 * M, (const float*)(p.ws + BIAS2), F2, nullptr};
        pg8::gemm_phase(glds, g, S, Ep);
    }
    SEAM(16);
    if (IN(17)) phase_conv(p, 1);
    SEAM(17);
    if (IN(18)) {
        pg8::Gemm g{(const bf16*)(AB + A_ACT), (const bf16*)(WB + W_RKV), FH, FH, FH, 0, 0};
        pg8::Order S; S.init(M / 192, 4, 1, G, c);
        if (G == 256) { pg8::EpiResFin Ep{p.out, p.out, MOD + 5 * 6144 + 5 * 1024, p.in[14], SSQ + 3 * M, (unsigned*)(SSQ + 4 * M)};
            pg8::gemm_phase<pg8::EpiResFin, 3>(glds, g, S, Ep); }
        else { pg8::EpiRes Ep{p.out, p.out + (size_t)MP * D, p.out, MOD + 5 * 6144 + 5 * 1024};
            pg8::gemm_phase<pg8::EpiRes, 3>(glds, g, S, Ep); }
    }
    if (G != 256) SEAM(18);
    for (int xs_ = 0; xs_ < XSYNC; ++xs_) xcd_barrier(xbar);
    if (G != 256 && IN(19)) phase_final(p);
#undef IN
#undef SEAM
}

extern "C" void kernel_launch(void* const* d_in, const int* in_sizes, int n_in, void* d_out, int out_size, void* d_ws, size_t ws_size, hipStream_t stream) {
    static int grid = 0;
    if (grid == 0) {
        if (n_in != 39 || ws_size < WS_NEED) { fprintf(stderr, "kernel_launch: expected 39 inputs and >= %zu bytes of workspace, got %d / %zu\n", (size_t)WS_NEED, n_in, ws_size); grid = -1; return; }
        int dev = 0, cus = 0, per_cu = 0;
        hipGetDevice(&dev);
        hipDeviceGetAttribute(&cus, hipDeviceAttributeMultiprocessorCount, dev);
        if (hipFuncSetAttribute((const void*)mk_fwd, hipFuncAttributeMaxDynamicSharedMemorySize, LDS_BYTES) != hipSuccess) { fprintf(stderr, "kernel_launch: hipFuncSetAttribute failed\n"); grid = -1; return; }
        if (hipOccupancyMaxActiveBlocksPerMultiprocessor(&per_cu, (const void*)mk_fwd, 512, LDS_BYTES) != hipSuccess || per_cu < 1) { fprintf(stderr, "kernel_launch: occupancy query failed (%d)\n", per_cu); per_cu = 1; }
        (void)hipGetLastError();
        grid = cus * per_cu;
        if (grid > 256) grid = 256;
    }
    if (grid < 0) return;
    Params p{};
    for (int i = 0; i < 39; ++i) p.in[i] = (const float*)d_in[i];
    p.out = (float*)d_out; p.ws = (unsigned char*)d_ws;
#if ONE_LAUNCH
    (void)hipMemsetAsync((char*)d_ws + OFF_BAR, 0, 16384, stream);
    p.ph_lo = 0; p.ph_hi = NPH;
    void* args[] = {&p};
    hipError_t e = hipLaunchCooperativeKernel((const void*)mk_fwd, dim3(grid), dim3(512), args, LDS_BYTES, stream);
    if (e != hipSuccess) fprintf(stderr, "cooperative launch failed: %s (grid %d)\n", hipGetErrorString(e), grid);
#else
    static const int order[NPH] = {0, 1, 2, 3, 4, 5, 6, 7, 8, 9, 10, 11, 12, 20, 13, 14, 15, 16, 17, 18, 19};
    for (int kk = 0; kk < NPH; ++kk) {
        const int k = order[kk];
        p.ph_lo = k; p.ph_hi = k + 1;
        hipLaunchKernelGGL(mk_fwd, dim3(grid), dim3(512), LDS_BYTES, stream, p);
    }
#endif
}
```
